# Optimizing an MI355X kernel written in HIP

```python
import math
import jax, jax.numpy as jnp
from jax import lax
import numpy as np

D_MODEL = 2048
BATCH = 1
SEQ = 8192
DEPTH = 1

GMLP_CHUNK = 128
GMLP_GROUPS = 4
GMLP_GROUP_DIM = 128
GMLP_WIDTH = GMLP_GROUPS * GMLP_GROUP_DIM

DN_HEADS = 8
DN_HEAD_DIM = 128
DN_WIDTH = DN_HEADS * DN_HEAD_DIM
DN_CONV = 4
DN_CHUNK = 64

XA_HEADS = 4
XA_HEAD_DIM = 128
XA_WIDTH = XA_HEADS * XA_HEAD_DIM
N_MEM = 256

MIX_WIDTH = GMLP_WIDTH + DN_WIDTH + XA_WIDTH
EPS = 1e-6

SEG_WIDTHS = (GMLP_WIDTH, GMLP_WIDTH, GMLP_WIDTH,
              DN_WIDTH, DN_WIDTH, DN_WIDTH, DN_WIDTH, DN_HEADS, DN_HEADS,
              XA_WIDTH, XA_WIDTH)
IN_WIDTH = sum(SEG_WIDTHS)
SPLIT_POINTS = tuple(sum(SEG_WIDTHS[:i + 1]) for i in range(len(SEG_WIDTHS) - 1))

kernel_name = "hybrid_gmlp_gated_deltanet_memxattn_block"


def rmsnorm(x, g):
    xf = x.astype(jnp.float32)
    y = xf * lax.rsqrt(jnp.mean(xf * xf, axis=-1, keepdims=True) + EPS)
    return (y * g.astype(jnp.float32)).astype(x.dtype)


def layernorm(x, g, b):
    xf = x.astype(jnp.float32)
    mu = jnp.mean(xf, axis=-1, keepdims=True)
    xc = xf - mu
    y = xc * lax.rsqrt(jnp.mean(xc * xc, axis=-1, keepdims=True) + EPS)
    return (y * g.astype(jnp.float32) + b.astype(jnp.float32)).astype(x.dtype)


def l2norm(x):
    xf = x.astype(jnp.float32)
    return xf * lax.rsqrt(jnp.sum(xf * xf, axis=-1, keepdims=True) + EPS)


def gmlp_spatial_gating(u, v, ws, bs, ln_g, ln_b):
    B, S, _ = u.shape
    u = jax.nn.gelu(u)
    v = layernorm(jax.nn.gelu(v), ln_g, ln_b)
    nc = S // GMLP_CHUNK
    v = v.reshape(B, nc, GMLP_CHUNK, GMLP_GROUPS, GMLP_GROUP_DIM)
    causal = jnp.tril(jnp.ones((GMLP_CHUNK, GMLP_CHUNK), dtype=bool))
    w = jnp.where(causal[None], ws, 0)
    s = jnp.einsum('gts,bcsgd->bctgd', w, v) + bs.T[None, None, :, :, None]
    return u * s.reshape(B, S, GMLP_WIDTH)


def causal_conv_silu(x, w):
    K = w.shape[0]
    S = x.shape[1]
    xp = jnp.pad(x, ((0, 0), (K - 1, 0), (0, 0)))
    y = sum(w[k] * xp[:, k:k + S] for k in range(K))
    return jax.nn.silu(y)


def gated_delta_rule(q, k, v, g, beta):
    f32 = jnp.float32
    q, k, v, g, beta = (t.astype(f32) for t in (q, k, v, g, beta))
    B, H, S, Dk = q.shape
    Dv = v.shape[-1]
    C = DN_CHUNK
    N = S // C
    q = q.reshape(B, H, N, C, Dk)
    k = k.reshape(B, H, N, C, Dk)
    v = v.reshape(B, H, N, C, Dv)
    g = g.reshape(B, H, N, C)
    beta = beta.reshape(B, H, N, C)

    g_cum = jnp.cumsum(g, axis=-1)
    tri = jnp.tril(jnp.ones((C, C), dtype=bool))
    strict = jnp.tril(jnp.ones((C, C), dtype=bool), k=-1)
    diff = g_cum[..., :, None] - g_cum[..., None, :]
    decay = jnp.exp(jnp.where(tri, diff, -jnp.inf))

    kb = k * beta[..., None]
    vb = v * beta[..., None]
    a = jnp.where(strict, jnp.einsum('bhnid,bhnjd->bhnij', kb, k) * decay, 0.0)
    eye = jnp.eye(C, dtype=f32)
    T = lax.linalg.triangular_solve(a + eye, jnp.broadcast_to(eye, a.shape),
                                    left_side=True, lower=True, unit_diagonal=True)
    value = jnp.einsum('bhnij,bhnjd->bhnid', T, vb)
    k_cumdecay = jnp.einsum('bhnij,bhnjd->bhnid', T, kb * jnp.exp(g_cum)[..., None])
    attn_intra = jnp.where(tri, jnp.einsum('bhnid,bhnjd->bhnij', q, k) * decay, 0.0)
    q_g = q * jnp.exp(g_cum)[..., None]
    g_last = g_cum[..., -1]
    k_dec = k * jnp.exp(g_last[..., None] - g_cum)[..., None]

    def step(state, inp):
        qg_c, kcd_c, val_c, ai_c, kd_c, gl_c = inp
        v_new = val_c - jnp.einsum('bhid,bhde->bhie', kcd_c, state)
        o_c = jnp.einsum('bhid,bhde->bhie', qg_c, state) + jnp.einsum('bhij,bhje->bhie', ai_c, v_new)
        state = state * jnp.exp(gl_c)[..., None, None] + jnp.einsum('bhid,bhie->bhde', kd_c, v_new)
        return state, o_c

    xs = tuple(jnp.moveaxis(t, 2, 0) for t in (q_g, k_cumdecay, value, attn_intra, k_dec, g_last))
    s0 = jnp.zeros((B, H, Dk, Dv), f32)
    _, o = lax.scan(step, s0, xs)
    return jnp.moveaxis(o, 0, 2).reshape(B, H, S, Dv)


def setup_inputs(seed: int = 0) -> dict:
    key = jax.random.key(seed)
    ks = jax.random.split(key, 16)
    f32 = jnp.float32
    nrm = lambda k_, shp: jax.random.normal(k_, shp, f32)
    x = nrm(ks[0], (BATCH, SEQ, D_MODEL))
    mem = nrm(ks[1], (BATCH, N_MEM, D_MODEL))
    ln_g = 1.0 + 0.1 * nrm(ks[2], (DEPTH, D_MODEL))
    w_in = nrm(ks[3], (DEPTH, D_MODEL, IN_WIDTH)) * D_MODEL ** -0.5
    gmlp_ln_g = 1.0 + 0.1 * nrm(ks[4], (DEPTH, GMLP_WIDTH))
    gmlp_ln_b = 0.1 * nrm(ks[5], (DEPTH, GMLP_WIDTH))
    gmlp_ws = nrm(ks[6], (DEPTH, GMLP_GROUPS, GMLP_CHUNK, GMLP_CHUNK)) * GMLP_CHUNK ** -0.5
    gmlp_bs = 1.0 + 0.1 * nrm(ks[7], (DEPTH, GMLP_GROUPS, GMLP_CHUNK))
    conv_w = nrm(ks[8], (DEPTH, DN_CONV, 3 * DN_WIDTH)) * DN_CONV ** -0.5
    dn_a_log = jnp.log(jax.random.uniform(ks[9], (DEPTH, DN_HEADS), f32, minval=1.0, maxval=16.0))
    dt = jnp.exp(jax.random.uniform(ks[10], (DEPTH, DN_HEADS), f32,
                                    minval=math.log(1e-3), maxval=math.log(1e-1)))
    dn_dt_bias = dt + jnp.log(-jnp.expm1(-dt))
    dn_norm_g = 1.0 + 0.1 * nrm(ks[11], (DEPTH, DN_HEAD_DIM))
    mem_norm_g = 1.0 + 0.1 * nrm(ks[12], (DEPTH, D_MODEL))
    w_mem_kv = nrm(ks[13], (DEPTH, D_MODEL, 2 * XA_WIDTH)) * D_MODEL ** -0.5
    w_out = nrm(ks[14], (DEPTH, MIX_WIDTH, D_MODEL)) * MIX_WIDTH ** -0.5
    final_g = 1.0 + 0.1 * nrm(ks[15], (D_MODEL,))
    return {"x": x, "mem": mem, "ln_g": ln_g, "w_in": w_in,
            "gmlp_ln_g": gmlp_ln_g, "gmlp_ln_b": gmlp_ln_b, "gmlp_ws": gmlp_ws, "gmlp_bs": gmlp_bs,
            "conv_w": conv_w, "dn_a_log": dn_a_log, "dn_dt_bias": dn_dt_bias, "dn_norm_g": dn_norm_g,
            "mem_norm_g": mem_norm_g, "w_mem_kv": w_mem_kv, "w_out": w_out, "final_g": final_g}


def reference(x, mem, ln_g, w_in, gmlp_ln_g, gmlp_ln_b, gmlp_ws, gmlp_bs, conv_w, dn_a_log,
              dn_dt_bias, dn_norm_g, mem_norm_g, w_mem_kv, w_out, final_g):
    B, S, _ = x.shape
    M = mem.shape[1]
    for l in range(DEPTH):
        h = rmsnorm(x, ln_g[l])
        proj = h @ w_in[l]
        (g_u, g_v, g_z, d_q, d_k, d_v, d_z, d_a, d_b, c_q, c_z) = jnp.split(proj, SPLIT_POINTS, axis=-1)

        out_a = gmlp_spatial_gating(g_u, g_v, gmlp_ws[l], gmlp_bs[l], gmlp_ln_g[l], gmlp_ln_b[l]) * jax.nn.silu(g_z)

        qkv = causal_conv_silu(jnp.concatenate([d_q, d_k, d_v], axis=-1), conv_w[l])
        q, k, v = jnp.split(qkv, 3, axis=-1)
        to_heads = lambda t: t.reshape(B, S, DN_HEADS, DN_HEAD_DIM).transpose(0, 2, 1, 3)
        q = l2norm(to_heads(q)) * DN_HEAD_DIM ** -0.5
        k = l2norm(to_heads(k))
        v = to_heads(v)
        g = -jnp.exp(dn_a_log[l].astype(jnp.float32)) * jax.nn.softplus(
            d_a.astype(jnp.float32) + dn_dt_bias[l].astype(jnp.float32))
        beta = jax.nn.sigmoid(d_b.astype(jnp.float32))
        o = gated_delta_rule(q, k, v, g.transpose(0, 2, 1), beta.transpose(0, 2, 1))
        o = o.transpose(0, 2, 1, 3).astype(x.dtype)
        o = rmsnorm(o, dn_norm_g[l]) * jax.nn.silu(d_z.reshape(B, S, DN_HEADS, DN_HEAD_DIM))
        out_b = o.reshape(B, S, DN_WIDTH)

        m = rmsnorm(mem, mem_norm_g[l])
        mk, mv = jnp.split(m @ w_mem_kv[l], 2, axis=-1)
        mk = mk.reshape(B, M, XA_HEADS, XA_HEAD_DIM)
        mv = mv.reshape(B, M, XA_HEADS, XA_HEAD_DIM)
        cq = c_q.reshape(B, S, XA_HEADS, XA_HEAD_DIM)
        scores = jnp.einsum('bshd,bmhd->bhsm', cq, mk).astype(jnp.float32) * XA_HEAD_DIM ** -0.5
        p = jax.nn.softmax(scores, axis=-1).astype(mv.dtype)
        out_c = jnp.einsum('bhsm,bmhd->bshd', p, mv).reshape(B, S, XA_WIDTH) * jax.nn.silu(c_z)

        mixed = jnp.concatenate([out_a, out_b, out_c], axis=-1)
        x = x + mixed @ w_out[l]
    return rmsnorm(x, final_g)
```

```cpp
#include <hip/hip_runtime.h>
#include <cstdio>
#include <cstdint>
#ifndef MK_N_LAUNCHES
#define MK_N_LAUNCHES 1
#endif
namespace pg8 {
#define PG8_LAS __attribute__((address_space(3)))
typedef unsigned short bf16_t;
typedef short bf16x8 __attribute__((ext_vector_type(8)));
typedef float f32x4 __attribute__((ext_vector_type(4)));
typedef unsigned u32x4 __attribute__((ext_vector_type(4)));
constexpr int BM = 256, BK = 64, HALF = 128, HTB = HALF * BK * 2  , STAGE_BYTES = 8 * HTB, NXCD = 8, WGM = 8;

__host__ __device__ __forceinline__ int lds_byte(int r, int c) { const int st = (r >> 4) * 2 + (c >> 5), rr = r & 15, cc = c & 31, ob = rr * 64 + cc * 2; return st * 1024 + (ob ^ (((ob >> 9) & 1) << 5)); }
__host__ __device__ __forceinline__ void stage_rc(int b, int& R, int& C) { const int st = b / 1024, sb = b % 1024, swz = sb ^ (((sb >> 9) & 1) << 5); R = (st >> 1) * 16 + swz / 64; C = (st & 1) * 32 + (swz % 64) / 2; }
__host__ __device__ __forceinline__ int perm32(int rho) { const int n = rho >> 4, i = rho & 15; return 8 * (i >> 2) + 4 * n + (i & 3); }

struct Unit { int pm, pn; };
struct Gemm { const bf16_t* A; const bf16_t* Bt; int M, N, K; };

struct StaticOrder {
    int nM, nN, nwg, G, c;
    __host__ __device__ void init(int M, int N, int G_, int c_) { nM = M / BM; nN = N / BM; nwg = nM * nN; G = G_; c = c_; }
    __host__ __device__ bool next(int i, Unit& u) const {
        const long L = (long)i * G + c; if (L >= nwg) return false;
        int wgid = (int)L; { const int q = nwg / NXCD, r = nwg % NXCD, xcd = wgid % NXCD, off = wgid / NXCD; wgid = (xcd < r ? xcd * (q + 1) : r * (q + 1) + (xcd - r) * q) + off; }
        const int nig = WGM * nN, gid = wgid / nig, fm = gid * WGM, gsz = (nM - fm) < WGM ? (nM - fm) : WGM;
        u.pm = fm + ((wgid % nig) % gsz); u.pn = (wgid % nig) / gsz; return true;
    }
    __device__ __forceinline__ void a_ready(const Unit&) const {}
    __device__ __forceinline__ void done(const Unit&) const {}
};

__device__ __forceinline__ unsigned cvt_pk_bf16(float lo, float hi) { unsigned r; asm volatile("v_cvt_pk_bf16_f32 %0, %1, %2" : "=v"(r) : "v"(lo), "v"(hi)); return r; }
struct EpiProj {
    static constexpr bool PERM = true, AFTER_DRAIN = false;
    bf16_t* P; float* AB; const float* rstd; bf16_t* MKV;
    __device__ __forceinline__ void operator()(const f32x4 (&acc)[2][2][4][2], const Unit& u, int wr, int wc, int fr, int fq) const {
        const int row0 = wr * 64 + fr; const bool memt = u.pm >= 32;
        const float* rsp = rstd + (memt ? 0 : u.pm * BM);
        if (u.pn != 26) {
            bf16_t* base = memt ? MKV + (size_t)(u.pn - 27) * BM : P + (size_t)u.pm * BM * 6656 + (size_t)u.pn * BM; const int ldc = memt ? 1024 : 6656;
            base += wc * 32 + 8 * fq;
#pragma unroll
            for (int ai = 0; ai < 2; ++ai)
#pragma unroll
                for (int m = 0; m < 4; ++m) { const int row = row0 + ai * HALF + m * 16; const float rs = memt ? 1.f : rsp[row]; bf16_t* rowp = base + (size_t)row * ldc;
#pragma unroll
                    for (int bj = 0; bj < 2; ++bj) { const f32x4 v0 = acc[ai][bj][m][0] * rs, v1 = acc[ai][bj][m][1] * rs;
                        u32x4 w; w.x = cvt_pk_bf16(v0[0], v0[1]); w.y = cvt_pk_bf16(v0[2], v0[3]); w.z = cvt_pk_bf16(v1[0], v1[1]); w.w = cvt_pk_bf16(v1[2], v1[3]);
                        *(u32x4*)(rowp + bj * HALF) = w; } }
        } else if (wc == 0 && fq < 2) {
#pragma unroll
            for (int ai = 0; ai < 2; ++ai)
#pragma unroll
                for (int m = 0; m < 4; ++m) { const int row = row0 + ai * HALF + m * 16; const float rs = rsp[row];
#pragma unroll
                    for (int n = 0; n < 2; ++n) *(f32x4*)(AB + (size_t)(u.pm * BM + row) * 16 + 8 * fq + 4 * n) = acc[ai][0][m][n] * rs; }
        }
    }
};
struct EpiRes {
    static constexpr bool PERM = false, AFTER_DRAIN = false;
    const float* X; float* O;
    __device__ __forceinline__ void operator()(const f32x4 (&acc)[2][2][4][2], const Unit& u, int wr, int wc, int fr, int fq) const {
        const int row0 = u.pm * BM + wr * 64 + fr, col0 = u.pn * BM + wc * 32 + 4 * fq;
#pragma unroll
        for (int ai = 0; ai < 2; ++ai)
#pragma unroll
            for (int m = 0; m < 4; ++m) { const size_t off = (size_t)(row0 + ai * HALF + m * 16) * 2048 + col0;
#pragma unroll
                for (int bj = 0; bj < 2; ++bj)
#pragma unroll
                    for (int n = 0; n < 2; ++n) { const f32x4 xv = *(const f32x4*)(X + off + bj * HALF + n * 16); *(f32x4*)(O + off + bj * HALF + n * 16) = xv + acc[ai][bj][m][n]; } }
    }
};
struct Order1 {
    StaticOrder so; int G, c;
    __device__ void init(int G_, int c_) { so.init(8192, 6912, G_, c_); G = G_; c = c_; }
    __device__ bool next(int i, Unit& u) const { const long L = (long)i * G + c; if (L < 864) return so.next(i, u); if (L < 868) { u.pm = 32; u.pn = 27 + (int)(L - 864); return true; } return false; }
    __device__ __forceinline__ void a_ready(const Unit&) const {}
    __device__ __forceinline__ void done(const Unit&) const {}
};
template <class Epi, class Sched, bool ALIGN_EPI = false, bool SP2 = false>
__device__ __forceinline__ void gemm_phase(PG8_LAS unsigned char* lds, const Gemm g, const Sched& S, const Epi& E) {
    const int tid = threadIdx.x, wid = __builtin_amdgcn_readfirstlane(tid >> 6), lane = tid & 63, wr = wid >> 2, wc = wid & 3, fr = lane & 15, fq = lane >> 4;
    const int K = g.K, nt = K / BK;
    unsigned voffA[2], voffB[2];
#pragma unroll
    for (int i = 0; i < 2; ++i) { int R, C; stage_rc(tid * 16 + i * 8192, R, C); const int Rb = Epi::PERM ? ((R & ~31) + perm32(R & 31)) : R;
        voffA[i] = (unsigned)(R * K + C) * 2u; voffB[i] = (unsigned)(Rb * K + C) * 2u; }
    const size_t kstep = (size_t)(BK * 2);
    const size_t hstep = (size_t)HALF * K * 2;
    const size_t tstep = 2 * hstep;
    const unsigned ldsw = (unsigned)wid * 1024u;
    const int aoff = lds_byte(wr * 64 + fr, fq * 8), boff = lds_byte(wc * 32 + fr, fq * 8);
#define PG8_SA(b, h) (((b) * 2 + (h)) * HTB)
#define PG8_SB(b, h) ((4 + (b) * 2 + (h)) * HTB)
#define PG8_STAGE(bufoff, gbase, voff) do { _Pragma("unroll") for (int _i = 0; _i < 2; ++_i) \
        __builtin_amdgcn_global_load_lds((const unsigned*)((const char*)(gbase) + (voff)[_i]), (PG8_LAS unsigned*)(lds + (bufoff) + ldsw + _i * 8192), 16, 0, 0); } while (0)
#define PG8_LDA(dst, b, h) do { _Pragma("unroll") for (int m = 0; m < 4; ++m) _Pragma("unroll") for (int k = 0; k < 2; ++k) dst[m][k] = *(const PG8_LAS bf16x8*)(lds + PG8_SA(b, h) + aoff + m * 2048 + k * 1024); } while (0)
#define PG8_LDB(dst, b, h) do { _Pragma("unroll") for (int n = 0; n < 2; ++n) _Pragma("unroll") for (int k = 0; k < 2; ++k) dst[n][k] = *(const PG8_LAS bf16x8*)(lds + PG8_SB(b, h) + boff + n * 2048 + k * 1024); } while (0)
#define PG8_MMA(ai, bj, At, Bt) do { __builtin_amdgcn_s_setprio(1); _Pragma("unroll") for (int m = 0; m < 4; ++m) _Pragma("unroll") for (int n = 0; n < 2; ++n) _Pragma("unroll") for (int k = 0; k < 2; ++k) \
        acc[ai][bj][m][n] = __builtin_amdgcn_mfma_f32_16x16x32_bf16(Bt[n][k], At[m][k], acc[ai][bj][m][n], 0, 0, 0); __builtin_amdgcn_s_setprio(0); } while (0)
#define PG8_WAIT_V(n) asm volatile("s_waitcnt vmcnt(" #n ")" ::: "memory")
#define PG8_WAIT_L(n) asm volatile("s_waitcnt lgkmcnt(" #n ")" ::: "memory")
#define PG8_BAR __builtin_amdgcn_s_barrier()
#define PG8_SCHED __builtin_amdgcn_sched_barrier(0)
    Unit cur, nxt; int ui = 0;
    if (!S.next(0, cur)) return;
    f32x4 acc[2][2][4][2];
#pragma unroll
    for (int a = 0; a < 2; ++a)
#pragma unroll
        for (int b = 0; b < 2; ++b)
#pragma unroll
            for (int m = 0; m < 4; ++m)
#pragma unroll
                for (int n = 0; n < 2; ++n) acc[a][b][m][n] = (f32x4){0.f, 0.f, 0.f, 0.f};
    bf16x8 At[4][2], B0[2][2], B1[2][2];
    const char* cA = (const char*)g.A + (size_t)cur.pm * tstep; const char* cB = (const char*)g.Bt + (size_t)cur.pn * tstep;
    S.a_ready(cur);
    if constexpr (SP2) {
        PG8_STAGE(PG8_SB(0, 0), cB, voffB); PG8_STAGE(PG8_SB(0, 1), cB + hstep, voffB); PG8_STAGE(PG8_SA(0, 0), cA, voffA); PG8_STAGE(PG8_SA(0, 1), cA + hstep, voffA);
        if (wr == 1) PG8_BAR;
        PG8_WAIT_V(2); PG8_BAR;
        PG8_STAGE(PG8_SB(1, 0), cB + kstep, voffB); PG8_STAGE(PG8_SA(1, 0), cA + kstep, voffA); PG8_STAGE(PG8_SB(1, 1), cB + hstep + kstep, voffB);
        PG8_WAIT_V(6); PG8_BAR;
    } else {
        PG8_STAGE(PG8_SB(0, 0), cB, voffB); PG8_STAGE(PG8_SA(0, 0), cA, voffA); PG8_STAGE(PG8_SB(0, 1), cB + hstep, voffB); PG8_STAGE(PG8_SA(0, 1), cA + hstep, voffA);
        if (wr == 1) PG8_BAR;
        PG8_WAIT_V(4); PG8_BAR;
        PG8_STAGE(PG8_SB(1, 0), cB + kstep, voffB); PG8_STAGE(PG8_SA(1, 0), cA + kstep, voffA); PG8_STAGE(PG8_SB(1, 1), cB + hstep + kstep, voffB);
        PG8_WAIT_V(6); PG8_BAR;
    }
    for (;;) {
        const bool has_next = S.next(ui + 1, nxt);
        const char* nA = has_next ? (const char*)g.A + (size_t)nxt.pm * tstep : cA; const char* nB = has_next ? (const char*)g.Bt + (size_t)nxt.pn * tstep : cB;
        for (int t = 0; t < nt; t += 2) {
            const bool last = (t == nt - 2);
            const char* a1 = cA + (size_t)(t + 1) * kstep;
            const char* a2 = last ? nA : cA + (size_t)(t + 2) * kstep; const char* b2 = last ? nB : cB + (size_t)(t + 2) * kstep;
            const char* a3 = a2 + kstep; const char* b3 = b2 + kstep;
            if (last && has_next) S.a_ready(nxt);
            if constexpr (SP2) {
            PG8_LDB(B0, 0, 0); PG8_LDB(B1, 0, 1); PG8_SCHED; PG8_LDA(At, 0, 0); PG8_STAGE(PG8_SA(1, 1), a1 + hstep, voffA);
            PG8_WAIT_V(8); PG8_WAIT_L(0); PG8_BAR; PG8_MMA(0, 0, At, B0); PG8_MMA(0, 1, At, B1); PG8_BAR; PG8_SCHED;
            PG8_LDA(At, 0, 1); PG8_STAGE(PG8_SB(0, 0), b2, voffB); PG8_STAGE(PG8_SB(0, 1), b2 + hstep, voffB); PG8_STAGE(PG8_SA(0, 0), a2, voffA);
            PG8_WAIT_V(8); PG8_WAIT_L(0); PG8_BAR; PG8_MMA(1, 0, At, B0); PG8_MMA(1, 1, At, B1); PG8_BAR; PG8_SCHED;
            PG8_LDB(B0, 1, 0); PG8_LDB(B1, 1, 1); PG8_SCHED; PG8_LDA(At, 1, 0); PG8_STAGE(PG8_SA(0, 1), a2 + hstep, voffA);
            PG8_WAIT_V(8); PG8_WAIT_L(0); PG8_BAR; PG8_MMA(0, 0, At, B0); PG8_MMA(0, 1, At, B1); PG8_BAR; PG8_SCHED;
            PG8_LDA(At, 1, 1); PG8_STAGE(PG8_SB(1, 0), b3, voffB); PG8_STAGE(PG8_SB(1, 1), b3 + hstep, voffB); PG8_STAGE(PG8_SA(1, 0), a3, voffA);
            PG8_WAIT_V(8); PG8_WAIT_L(0); PG8_BAR; PG8_MMA(1, 0, At, B0); PG8_MMA(1, 1, At, B1); PG8_BAR; PG8_SCHED;
            } else {
            PG8_LDB(B0, 0, 0); PG8_SCHED; PG8_LDA(At, 0, 0); PG8_STAGE(PG8_SA(1, 1), a1 + hstep, voffA);
            PG8_WAIT_L(8); PG8_BAR; PG8_WAIT_L(0); PG8_MMA(0, 0, At, B0); PG8_BAR; PG8_SCHED;
            PG8_LDB(B1, 0, 1); PG8_STAGE(PG8_SB(0, 0), b2, voffB);
            PG8_BAR; PG8_WAIT_L(0); PG8_MMA(0, 1, At, B1); PG8_BAR;
            PG8_LDA(At, 0, 1); PG8_STAGE(PG8_SA(0, 0), a2, voffA);
            PG8_BAR; PG8_WAIT_L(0); PG8_MMA(1, 0, At, B0); PG8_BAR; PG8_SCHED;
            PG8_STAGE(PG8_SB(0, 1), b2 + hstep, voffB);
            PG8_WAIT_V(6); PG8_BAR; PG8_MMA(1, 1, At, B1); PG8_BAR;
            PG8_LDB(B0, 1, 0); PG8_SCHED; PG8_LDA(At, 1, 0); PG8_STAGE(PG8_SA(0, 1), a2 + hstep, voffA);
            PG8_WAIT_L(8); PG8_BAR; PG8_WAIT_L(0); PG8_MMA(0, 0, At, B0); PG8_BAR; PG8_SCHED;
            PG8_LDB(B1, 1, 1); PG8_STAGE(PG8_SB(1, 0), b3, voffB);
            PG8_BAR; PG8_WAIT_L(0); PG8_MMA(0, 1, At, B1); PG8_BAR;
            PG8_LDA(At, 1, 1); PG8_STAGE(PG8_SA(1, 0), a3, voffA);
            PG8_BAR; PG8_WAIT_L(0); PG8_MMA(1, 0, At, B0); PG8_BAR; PG8_SCHED;
            PG8_STAGE(PG8_SB(1, 1), b3 + hstep, voffB);
            PG8_WAIT_V(6); PG8_BAR; PG8_MMA(1, 1, At, B1); PG8_BAR;
            }
        }
        if constexpr (ALIGN_EPI) { if (wr == 0) PG8_BAR; }
        if constexpr (!Epi::AFTER_DRAIN) { E(acc, cur, wr, wc, fr, fq); S.done(cur); }
        if (!has_next) break;
#pragma unroll
        for (int a = 0; a < 2; ++a)
#pragma unroll
            for (int b = 0; b < 2; ++b)
#pragma unroll
                for (int m = 0; m < 4; ++m)
#pragma unroll
                    for (int n = 0; n < 2; ++n) acc[a][b][m][n] = (f32x4){0.f, 0.f, 0.f, 0.f};
        cur = nxt; cA = nA; cB = nB; ++ui;
        if constexpr (ALIGN_EPI) { if (wr == 1) PG8_BAR; }
    }
    PG8_WAIT_V(0);
    if constexpr (!ALIGN_EPI) { if (wr == 0) PG8_BAR; }
    PG8_BAR;
    if constexpr (Epi::AFTER_DRAIN) { E.fused(acc, cur, wr, wc, fr, fq, lds, wid, lane); S.done(cur); }
#undef PG8_SA
#undef PG8_SB
#undef PG8_STAGE
#undef PG8_LDA
#undef PG8_LDB
#undef PG8_MMA
#undef PG8_WAIT_V
#undef PG8_WAIT_L
#undef PG8_BAR
#undef PG8_SCHED
}
}
constexpr int NWAVES = 8;
constexpr int N_LAUNCHES = MK_N_LAUNCHES;
constexpr int N_PHASES = 7;
constexpr int SEQ = 8192, DM = 2048, NIN = 6672, NPADC = 6912, PLD = 6656, NMEMT = 256;
constexpr int PC_GU = 0, PC_GV = 512, PC_GZ = 1024, PC_DQ = 1536, PC_DK = 2560, PC_DV = 3584, PC_DZ = 4608, PC_CQ = 5632, PC_CZ = 6144;
constexpr int MC_A = 0, MC_B = 512, MC_C = 1536;
constexpr float EPSF = 1e-6f;
constexpr size_t MiB = 1u << 20;
constexpr size_t WS_CTL = 0, CTL_ZERO_BYTES = 1 * MiB;
constexpr size_t WS_XB = 2 * MiB;
constexpr size_t WS_WTIN = 36 * MiB;
constexpr size_t WS_WTOUT = 68 * MiB;
constexpr size_t WS_RSTD = 76 * MiB;
constexpr size_t WS_AB = 76 * MiB + 65536;
constexpr size_t WS_GLX = 76 * MiB + 655360;
constexpr size_t WS_MKV = 77 * MiB;
constexpr size_t WS_P = 78 * MiB;
constexpr size_t WS_MIXED = 182 * MiB;
constexpr size_t WS_SG = 214 * MiB;
constexpr size_t WS_END = 246 * MiB;
constexpr size_t WS_AP = 2 * MiB;
constexpr size_t WS_BNT = 34 * MiB;
constexpr size_t OUT_QEFF = 0;
constexpr size_t OUT_OIN = 16 * MiB;
constexpr int CW_TMO = 0, CW_BAR = 4096;
constexpr int LDS_BYTES = 163840;
constexpr int LDSCTL_OFF = 162816, MISC_OFF = LDSCTL_OFF + 320;
#define GAS __attribute__((address_space(1)))
#define LAS __attribute__((address_space(3)))
typedef unsigned short bf16;
typedef unsigned v4u __attribute__((ext_vector_type(4)));
typedef float f32x4 __attribute__((ext_vector_type(4)));
typedef short bf16x8 __attribute__((ext_vector_type(8)));
typedef GAS unsigned gu32;
typedef GAS unsigned long long gu64;
#define RLX_AGENT __ATOMIC_RELAXED, __HIP_MEMORY_SCOPE_AGENT
#define LDS_WAIT() asm volatile("s_waitcnt lgkmcnt(0)" ::: "memory")
#define VM_WAIT() asm volatile("s_waitcnt vmcnt(0)" ::: "memory")
__device__ __forceinline__ unsigned long long rt() { return __builtin_amdgcn_s_memrealtime(); }
__device__ __forceinline__ unsigned f2bf(float f) { unsigned u = __builtin_bit_cast(unsigned, f); return (u + 0x7fffu + ((u >> 16) & 1u)) >> 16; }
__device__ __forceinline__ unsigned pk2(float lo, float hi) { return f2bf(lo) | (f2bf(hi) << 16); }

#define XB_TMO      128
#define XB_XCNT(j)  (256  + 64 * (j))
#define XB_XSUB(j)  (1280 + 64 * (j))
#define XB_XGEN(j)  (2304 + 64 * (j))
#define XB_TOP      3328
#define XB_TOPGEN   3392
#define XCD_BAR_WORDS 3456
#define XB_SPIN_CAP (1u << 18)

__device__ __forceinline__ unsigned xb_ld(unsigned* p)              { return __hip_atomic_load(p, __ATOMIC_RELAXED, __HIP_MEMORY_SCOPE_AGENT); }
__device__ __forceinline__ unsigned xb_add(unsigned* p, unsigned v) { return __hip_atomic_fetch_add(p, v, __ATOMIC_RELAXED, __HIP_MEMORY_SCOPE_AGENT); }
__device__ __forceinline__ unsigned xb_xcc_id() { return (unsigned)__builtin_amdgcn_s_getreg((3 << 11) | 20) & 0xFu; }
#define XB_SPIN(cond, bar) do { unsigned _sp = 0; while (cond) { __builtin_amdgcn_s_sleep(1); \
    if ((++_sp & 255u) == 0u) { if (xb_ld(&(bar)[XB_TMO])) break; if (_sp > XB_SPIN_CAP) { atomicAdd(&(bar)[XB_TMO], 1u); break; } } } } while (0)

struct XcdBarrier {
    unsigned* bar; unsigned x;
    volatile LAS unsigned* st;
};

__device__ __forceinline__ XcdBarrier xcd_barrier_post(unsigned* bar, volatile LAS unsigned* st) {
    XcdBarrier b; b.bar = bar; b.x = xb_xcc_id(); b.st = st;
    if (threadIdx.x == 0) (void)xb_add(&bar[XB_XCNT(b.x)], 1u);
    return b;
}
__device__ __forceinline__ void xcd_barrier_complete(unsigned* bar, unsigned x, unsigned& nloc, unsigned& nx) {
    const unsigned G = gridDim.x * gridDim.y * gridDim.z;
    unsigned sum, cnt, mine, sp = 0u;
    for (;;) {
        sum = 0u; cnt = 0u; mine = 0u;
#pragma unroll
        for (unsigned j = 0; j < 16; ++j) { const unsigned c = xb_ld(&bar[XB_XCNT(j)]); sum += c; cnt += (c > 0u) ? 1u : 0u; mine = (j == x) ? c : mine; }
        if (sum == G) break;
        __builtin_amdgcn_s_sleep(1);
        if ((++sp & 255u) == 0u) { if (xb_ld(&bar[XB_TMO])) break; if (sp > XB_SPIN_CAP) { atomicAdd(&bar[XB_TMO], 1u); break; } }
    }
    nloc = mine > 0u ? mine : 1u; nx = cnt > 0u ? cnt : 1u;
}

__device__ __forceinline__ void xcd_barrier(const XcdBarrier& b) {
    asm volatile("s_waitcnt vmcnt(0)" ::: "memory");
    __syncthreads();
    if (threadIdx.x == 0) {
        unsigned* bar = b.bar;
        __builtin_amdgcn_s_waitcnt(0);
        unsigned nloc = b.st[0], nx = b.st[1];
        if (nloc == 0u) { xcd_barrier_complete(bar, b.x, nloc, nx); b.st[0] = nloc; b.st[1] = nx; }
        const unsigned old = xb_add(&bar[XB_XSUB(b.x)], 1u);
        const unsigned gen = old / nloc;
        if (old + 1u == (gen + 1u) * nloc) {
            __builtin_amdgcn_fence(__ATOMIC_RELEASE, "agent");
            asm volatile("s_waitcnt vmcnt(0)" ::: "memory");
            const unsigned og = xb_add(&bar[XB_TOP], 1u);
            const unsigned tg = og / nx;
            if (og + 1u == (tg + 1u) * nx) xb_add(&bar[XB_TOPGEN], 1u);
            else XB_SPIN(xb_ld(&bar[XB_TOPGEN]) == tg, bar);
            __builtin_amdgcn_fence(__ATOMIC_ACQUIRE, "agent");
            xb_add(&bar[XB_XGEN(b.x)], 1u);
            asm volatile("s_waitcnt vmcnt(0)" ::: "memory");
        } else {
            XB_SPIN(xb_ld(&bar[XB_XGEN(b.x)]) == gen, bar);
            __builtin_amdgcn_fence(__ATOMIC_ACQUIRE, "agent");
            asm volatile("s_waitcnt vmcnt(0)" ::: "memory");
        }
    }
    __syncthreads();
}
struct Frame {
    LAS unsigned char* lds; volatile LAS unsigned* MISC;
    int tid, lane, wave, vcu, G;
    unsigned char* ws; float* out; const float* const* inp;
};
#define FIN(k) (F.inp[k])
#define F_x FIN(0)
#define F_mem FIN(1)
#define F_ln_g FIN(2)
#define F_w_in FIN(3)
#define F_gm_g FIN(4)
#define F_gm_b FIN(5)
#define F_gm_ws FIN(6)
#define F_gm_bs FIN(7)
#define F_conv_w FIN(8)
#define F_a_log FIN(9)
#define F_dt_bias FIN(10)
#define F_dn_g FIN(11)
#define F_mem_g FIN(12)
#define F_w_mem FIN(13)
#define F_w_out FIN(14)
#define F_final_g FIN(15)
#define F_ctl ((gu32*)(F.ws + WS_CTL))
#define F_XB ((bf16*)(F.ws + WS_XB))
#define F_WTIN ((bf16*)(F.ws + WS_WTIN))
#define F_WTOUT ((bf16*)(F.ws + WS_WTOUT))
#define F_MKV ((bf16*)(F.ws + WS_MKV))
#define F_P ((bf16*)(F.ws + WS_P))
#define F_MIXED ((bf16*)(F.ws + WS_MIXED))
#define F_SG ((bf16*)(F.ws + WS_SG))
#define F_AP ((bf16*)(F.ws + WS_AP))
#define F_BNT ((bf16*)(F.ws + WS_BNT))
#define F_QEFF ((bf16*)((unsigned char*)F.out + OUT_QEFF))
#define F_OIN ((bf16*)((unsigned char*)F.out + OUT_OIN))
#define F_RSTD ((float*)(F.ws + WS_RSTD))
#define F_AB ((float*)(F.ws + WS_AB))
#define F_GLX ((float*)(F.ws + WS_GLX))
#define DI __device__ __forceinline__
typedef unsigned u32x2 __attribute__((ext_vector_type(2)));
typedef float f32x2 __attribute__((ext_vector_type(2)));
typedef __bf16 bf16x2_t __attribute__((ext_vector_type(2)));
DI unsigned cvtpk(float lo, float hi) { const f32x2 f = {lo, hi}; const bf16x2_t v = __builtin_convertvector(f, bf16x2_t); return __builtin_bit_cast(unsigned, v); }
DI float bflo(unsigned w) { return __builtin_bit_cast(float, w << 16); }
DI float bfhi(unsigned w) { return __builtin_bit_cast(float, w & 0xffff0000u); }
DI float bf1(bf16 h) { return __builtin_bit_cast(float, (unsigned)h << 16); }
DI float fexp(float x) { return __builtin_amdgcn_exp2f(x * 1.44269504089f); }
DI float frcp(float x) { return __builtin_amdgcn_rcpf(x); }
DI float sigm(float x) { return frcp(1.f + fexp(-x)); }
DI float silu_f(float x) { return x * sigm(x); }
DI float gelu_f(float x) { const float y = 1.5957691216057308f * (x + 0.044715f * x * x * x); return x * sigm(y); }
DI float softplus_f(float x) { return fmaxf(x, 0.f) + __logf(1.f + fexp(-fabsf(x))); }
DI float wave_sum(float v) {
#pragma unroll
    for (int o = 1; o < 64; o <<= 1) v += __shfl_xor(v, o);
    return v;
}
#define MFMA16(a, b, c) __builtin_amdgcn_mfma_f32_16x16x32_bf16((a), (b), (c), 0, 0, 0)
#define LDSW() asm volatile("s_waitcnt lgkmcnt(0)" ::: "memory")
DI void wg_sync() { __syncthreads(); }
DI f32x4 tile16(const LAS unsigned char* A, int lda, const LAS unsigned char* B, int ldb, int ksteps, f32x4 acc, int r, int q) {
    const LAS unsigned char* pa = A + r * lda + 16 * q; const LAS unsigned char* pb = B + r * ldb + 16 * q;
    for (int k = 0; k < ksteps; ++k) { const bf16x8 a = *(const LAS bf16x8*)(pa + 64 * k), b = *(const LAS bf16x8*)(pb + 64 * k); acc = MFMA16(a, b, acc); }
    return acc;
}

template <int MODE  >
DI void p0_transpose_item(const float* W, int srcN, int nblk, const float* g, bf16* WT, int row_off, LAS float* scr, int item, int lane) {
    const int kb = item / nblk, nb = item % nblk, k0 = 64 * kb, n0 = 32 * nb;
    const int np = n0 + (lane & 31);
    int sc = np; bool valid = true;
    if (MODE == 0) { sc = np < 5632 ? np : (np < 6656 ? np + 16 : 5632 + (np - 6656)); valid = np < NIN; }
#pragma unroll 8
    for (int i = 0; i < 32; ++i) { const int kk = 2 * i + (lane >> 5); float v = 0.f; if (valid) { v = W[(size_t)(k0 + kk) * srcN + sc]; if (MODE == 0) v *= g[k0 + kk]; } scr[kk * 33 + (lane & 31)] = v; }
    LDSW();
    const int c = lane & 7;
#pragma unroll
    for (int j = 0; j < 4; ++j) { const int n = (lane >> 3) + 8 * j; const LAS float* s = scr + (8 * c) * 33 + n;
        v4u o; o.x = cvtpk(s[0 * 33], s[1 * 33]); o.y = cvtpk(s[2 * 33], s[3 * 33]); o.z = cvtpk(s[4 * 33], s[5 * 33]); o.w = cvtpk(s[6 * 33], s[7 * 33]);
        *(GAS v4u*)(WT + (size_t)(row_off + n0 + n) * DM + k0 + 8 * c) = o; }
    LDSW();
}
DI void p0_row(const float* xrow, bf16* orow, const float* g, float* rstd_out, int lane) {
    const GAS f32x4* xr = (const GAS f32x4*)xrow + lane;
    f32x4 v[8]; float s = 0.f;
#pragma unroll
    for (int j = 0; j < 8; ++j) { v[j] = xr[64 * j]; s += (v[j].x * v[j].x + v[j].y * v[j].y) + (v[j].z * v[j].z + v[j].w * v[j].w); }
    const float rs = 1.f / sqrtf(wave_sum(s) * (1.f / DM) + EPSF);
    if (rstd_out && lane == 0) *rstd_out = rs;
    GAS u32x2* o8 = (GAS u32x2*)orow + lane;
#pragma unroll
    for (int j = 0; j < 8; ++j) { f32x4 w = v[j]; if (g) { const f32x4 gg = ((const GAS f32x4*)g)[64 * j + lane]; w = w * rs * gg; }
        u32x2 o; o.x = cvtpk(w.x, w.y); o.y = cvtpk(w.z, w.w); o8[64 * j] = o; }
}
DI void p0_prologue(Frame& F) {
    LAS float* scr = (LAS float*)(F.lds + F.wave * 16384);
    const int gw = F.vcu * NWAVES + F.wave, NGW = F.G * NWAVES;
    constexpr int NB_IN = 209, I_IN = 32 * NB_IN, I_MEM = 32 * 32, I_OUT = 32 * 64, NITEMS = I_IN + I_MEM + I_OUT;
    for (int it = gw; it < NITEMS; it += NGW) {
        int r = it;
        if (r < I_IN) { p0_transpose_item<0>(F_w_in, NIN, NB_IN, F_ln_g, F_WTIN, 0, scr, r, F.lane); continue; } r -= I_IN;
        if (r < I_MEM) { p0_transpose_item<1>(F_w_mem, 1024, 32, nullptr, F_WTIN, NPADC, scr, r, F.lane); continue; } r -= I_MEM;
        p0_transpose_item<1>(F_w_out, 2048, 64, nullptr, F_WTOUT, 0, scr, r, F.lane);
    }
    { GAS v4u* z = (GAS v4u*)(F_WTIN + (size_t)6688 * DM); const int n16 = (NPADC - 6688) * DM * 2 / 16;
      for (int i = gw * 64 + F.lane; i < n16; i += NGW * 64) z[i] = (v4u){0u, 0u, 0u, 0u}; }
    for (int m = gw; m < SEQ + NMEMT; m += NGW) {
        if (m < SEQ) p0_row(F_x + (size_t)m * DM, F_XB + (size_t)m * DM, nullptr, F_RSTD + m, F.lane);
        else p0_row(F_mem + (size_t)(m - SEQ) * DM, F_XB + (size_t)m * DM, F_mem_g, nullptr, F.lane);
    }
}

DI void gmlp_item(Frame& F, int item) {
    int lane_ = F.lane, tid_ = F.tid; asm volatile("" : "+v"(lane_), "+v"(tid_));
    const int c = item >> 2, g = item & 3, t0 = 128 * c, lane = lane_, w = F.wave, r = lane & 15, q = lane >> 4;
    LAS unsigned char* Wb = F.lds; LAS unsigned char* VT = F.lds + 34816;
    { const float* Wg = F_gm_ws + (size_t)g * 16384;
#pragma unroll
      for (int i = 0; i < 8; ++i) { const int e = tid_ * 4 + i * 2048, row = e >> 7, col = e & 127; const f32x4 v = *(const GAS f32x4*)(Wg + e);
          u32x2 o; o.x = cvtpk(col <= row ? v.x : 0.f, col + 1 <= row ? v.y : 0.f); o.y = cvtpk(col + 2 <= row ? v.z : 0.f, col + 3 <= row ? v.w : 0.f);
          *(LAS u32x2*)(Wb + row * 272 + col * 2) = o; } }
#pragma unroll 1
    for (int i = 0; i < 16; ++i) { const int s = 16 * w + i;
        const v4u raw = *(const GAS v4u*)(F_P + (size_t)(t0 + s) * PLD + PC_GV + 8 * lane);
        float gv[8]; gv[0] = gelu_f(bflo(raw.x)); gv[1] = gelu_f(bfhi(raw.x)); gv[2] = gelu_f(bflo(raw.y)); gv[3] = gelu_f(bfhi(raw.y));
        gv[4] = gelu_f(bflo(raw.z)); gv[5] = gelu_f(bfhi(raw.z)); gv[6] = gelu_f(bflo(raw.w)); gv[7] = gelu_f(bfhi(raw.w));
        float sm = 0.f;
#pragma unroll
        for (int j = 0; j < 8; ++j) sm += gv[j];
        const float mean = wave_sum(sm) * (1.f / 512.f); float sq = 0.f;
#pragma unroll
        for (int j = 0; j < 8; ++j) { gv[j] -= mean; sq += gv[j] * gv[j]; }
        const float rs = 1.f / sqrtf(wave_sum(sq) * (1.f / 512.f) + EPSF);
        if ((lane >> 4) == g) {
#pragma unroll
            for (int j = 0; j < 8; ++j) { const int d = 8 * (lane & 15) + j; const float val = gv[j] * rs * F_gm_g[128 * g + d] + F_gm_b[128 * g + d];
                *(LAS unsigned short*)(VT + d * 272 + s * 2) = (unsigned short)cvtpk(val, 0.f); } }
    }
    LDSW(); wg_sync();
    f32x4 acc[8]; const int ks = (w >> 1) + 1;
#pragma unroll
    for (int dt = 0; dt < 8; ++dt) { acc[dt] = (f32x4){0.f, 0.f, 0.f, 0.f}; acc[dt] = tile16(VT + 16 * dt * 272, 272, Wb + 16 * w * 272, 272, ks, acc[dt], r, q); }
    { const int tl = 16 * w + r, t = t0 + tl; const float bsv = F_gm_bs[g * 128 + tl];
      const bf16* prow = F_P + (size_t)t * PLD + 128 * g + 4 * q; bf16* orow = F_MIXED + (size_t)t * DM + MC_A + 128 * g + 4 * q;
#pragma unroll
      for (int dt = 0; dt < 8; ++dt) { const u32x2 u = *(const GAS u32x2*)(prow + PC_GU + 16 * dt), z = *(const GAS u32x2*)(prow + PC_GZ + 16 * dt);
          const float o0 = gelu_f(bflo(u.x)) * (acc[dt][0] + bsv) * silu_f(bflo(z.x)), o1 = gelu_f(bfhi(u.x)) * (acc[dt][1] + bsv) * silu_f(bfhi(z.x));
          const float o2 = gelu_f(bflo(u.y)) * (acc[dt][2] + bsv) * silu_f(bflo(z.y)), o3 = gelu_f(bfhi(u.y)) * (acc[dt][3] + bsv) * silu_f(bfhi(z.y));
          u32x2 o; o.x = cvtpk(o0, o1); o.y = cvtpk(o2, o3); *(GAS u32x2*)(orow + 16 * dt) = o; } }
    wg_sync();
}

DI void xattn_item(Frame& F, int item) {
    int lane_ = F.lane, tid_ = F.tid; asm volatile("" : "+v"(lane_), "+v"(tid_));
    const int h = item & 3, qb = item >> 2, t0 = 128 * qb, lane = lane_, w = F.wave, r = lane & 15, q = lane >> 4;
    LAS unsigned char* KL = F.lds; LAS unsigned char* VL = F.lds + 69632;
    { const bf16* mk = F_MKV + 128 * h; const bf16* mv = F_MKV + 512 + 128 * h;
#pragma unroll
      for (int i = 0; i < 8; ++i) { const int c = tid_ + 512 * i, key = c >> 4, ch = c & 15;
          *(LAS v4u*)(KL + key * 272 + ch * 16) = *(const GAS v4u*)(mk + (size_t)key * 1024 + ch * 8);
          const v4u vv = *(const GAS v4u*)(mv + (size_t)key * 1024 + ch * 8); LAS unsigned char* vp = VL + (ch * 8) * 528 + key * 2;
          *(LAS unsigned short*)(vp) = (unsigned short)vv.x; *(LAS unsigned short*)(vp + 528) = (unsigned short)(vv.x >> 16);
          *(LAS unsigned short*)(vp + 2 * 528) = (unsigned short)vv.y; *(LAS unsigned short*)(vp + 3 * 528) = (unsigned short)(vv.y >> 16);
          *(LAS unsigned short*)(vp + 4 * 528) = (unsigned short)vv.z; *(LAS unsigned short*)(vp + 5 * 528) = (unsigned short)(vv.z >> 16);
          *(LAS unsigned short*)(vp + 6 * 528) = (unsigned short)vv.w; *(LAS unsigned short*)(vp + 7 * 528) = (unsigned short)(vv.w >> 16); } }
    const int t = t0 + 16 * w + r;
    bf16x8 bq[4];
#pragma unroll
    for (int ks = 0; ks < 4; ++ks) bq[ks] = *(const GAS bf16x8*)(F_P + (size_t)t * PLD + PC_CQ + 128 * h + 32 * ks + 8 * q);
    LDSW(); wg_sync();
    f32x4 s[16];
#pragma unroll
    for (int kt = 0; kt < 16; ++kt) { s[kt] = (f32x4){0.f, 0.f, 0.f, 0.f};
#pragma unroll
        for (int ks = 0; ks < 4; ++ks) { const bf16x8 a = *(const LAS bf16x8*)(KL + (16 * kt + r) * 272 + 64 * ks + 16 * q); s[kt] = MFMA16(a, bq[ks], s[kt]); }
        if (kt & 1) __builtin_amdgcn_sched_barrier(0); }
    float mx = -3.0e38f;
#pragma unroll
    for (int kt = 0; kt < 16; ++kt) mx = fmaxf(fmaxf(fmaxf(s[kt][0], s[kt][1]), fmaxf(s[kt][2], s[kt][3])), mx);
    mx = fmaxf(mx, __shfl_xor(mx, 16)); mx = fmaxf(mx, __shfl_xor(mx, 32));
    const float sc = 0.08838834764831845f * 1.44269504089f; float l = 0.f;
#pragma unroll
    for (int kt = 0; kt < 16; ++kt)
#pragma unroll
        for (int j = 0; j < 4; ++j) { const float p = __builtin_amdgcn_exp2f((s[kt][j] - mx) * sc); s[kt][j] = p; l += p; }
    l += __shfl_xor(l, 16); l += __shfl_xor(l, 32);
    f32x4 o[8];
#pragma unroll
    for (int dt = 0; dt < 8; ++dt) o[dt] = (f32x4){0.f, 0.f, 0.f, 0.f};
#pragma unroll
    for (int kk = 0; kk < 8; ++kk) {
        v4u pw; pw.x = cvtpk(s[2 * kk][0], s[2 * kk][1]); pw.y = cvtpk(s[2 * kk][2], s[2 * kk][3]); pw.z = cvtpk(s[2 * kk + 1][0], s[2 * kk + 1][1]); pw.w = cvtpk(s[2 * kk + 1][2], s[2 * kk + 1][3]);
        const bf16x8 bp = __builtin_bit_cast(bf16x8, pw);
#pragma unroll
        for (int dt = 0; dt < 8; ++dt) { const LAS unsigned char* vp = VL + (16 * dt + r) * 528 + 64 * kk + 8 * q;
            const u32x2 lo = *(const LAS u32x2*)vp, hi = *(const LAS u32x2*)(vp + 32);
            v4u av; av.x = lo.x; av.y = lo.y; av.z = hi.x; av.w = hi.y;
            o[dt] = MFMA16(__builtin_bit_cast(bf16x8, av), bp, o[dt]); }
        __builtin_amdgcn_sched_barrier(0); }
    { const float inv = 1.f / l; const bf16* zrow = F_P + (size_t)t * PLD + PC_CZ + 128 * h + 4 * q; bf16* orow = F_MIXED + (size_t)t * DM + MC_C + 128 * h + 4 * q;
#pragma unroll
      for (int dt = 0; dt < 8; ++dt) { const u32x2 z = *(const GAS u32x2*)(zrow + 16 * dt);
          u32x2 ov; ov.x = cvtpk(o[dt][0] * inv * silu_f(bflo(z.x)), o[dt][1] * inv * silu_f(bfhi(z.x))); ov.y = cvtpk(o[dt][2] * inv * silu_f(bflo(z.y)), o[dt][3] * inv * silu_f(bfhi(z.y)));
          *(GAS u32x2*)(orow + 16 * dt) = ov; } }
    wg_sync();
}
constexpr int L_KB = 0, L_QB = 17408, L_KT = 34816, L_VT = 52224, L_GT = 70656, L_DT = 89088, L_AF = 107520, L_TB = 124928, L_AI = 134144, L_SM = 143360, L_SS = 145408;
DI void dnprep_item(Frame& F, int item) {
    int lane_ = F.lane, tid_ = F.tid; asm volatile("" : "+v"(lane_), "+v"(tid_));
    const int h = item >> 7, n = item & 127, t0 = 64 * n, lane = lane_, w = F.wave, tid = tid_, r = lane & 15, q = lane >> 4;
    LAS unsigned char* L = F.lds;
    LAS float* gcs = (LAS float*)(L + L_SM); LAS float* bts = gcs + 64; LAS float* ssq = gcs + 128;
    LAS float* TF = (LAS float*)(L + L_KT); LAS float* AF = (LAS float*)(L + L_AF); LAS float* SS = (LAS float*)(L + L_SS);
    if (w == 0) {
#if defined(DBG_AB)
        float a = 0.f, b = 0.f;
        { const float* xr = F_x + (size_t)(t0 + lane) * DM; const float* wi = F_w_in; const float* lg = F_ln_g; float ssx = 0.f;
          for (int k = 0; k < DM; ++k) { const float xv_ = xr[k]; ssx += xv_ * xv_; const float hk = xv_ * lg[k]; a += hk * wi[(size_t)k * NIN + 5632 + h]; b += hk * wi[(size_t)k * NIN + 5640 + h]; }
          const float rs_ = 1.f / sqrtf(ssx * (1.f / DM) + EPSF); a *= rs_; b *= rs_; }
#else
        const float a = F_AB[(size_t)(t0 + lane) * 16 + h], b = F_AB[(size_t)(t0 + lane) * 16 + 8 + h];
#endif
        float g = -__expf(F_a_log[h]) * softplus_f(a + F_dt_bias[h]);
#pragma unroll
        for (int o = 1; o < 64; o <<= 1) { const float u = __shfl_up(g, o); if (lane >= o) g += u; }
        gcs[lane] = g; bts[lane] = sigm(b);
        if (lane == 63) F_GLX[item] = __expf(g);
    }
    for (int i = tid; i < 9216 / 4; i += 512) ((LAS unsigned*)(L + L_TB))[i] = 0u;
    const int d = tid & 127, oct = tid >> 7;
    LDSW(); wg_sync();
    const float gl = gcs[63];
#pragma unroll 1
    for (int p = 0; p < 2; ++p) { const int tb = 8 * (oct + 4 * p);
        float yq[8], yk[8];
#pragma unroll
        for (int sgi = 0; sgi < 3; ++sgi) { const int col = (sgi == 0 ? PC_DQ : (sgi == 1 ? PC_DK : PC_DV)) + 128 * h + d; const int cw = sgi * 1024 + 128 * h + d;
            const float w0 = F_conv_w[cw], w1 = F_conv_w[3072 + cw], w2 = F_conv_w[6144 + cw], w3 = F_conv_w[9216 + cw];
            float xv[11];
#pragma unroll
            for (int j = 0; j < 11; ++j) { const int tt = t0 + tb - 3 + j, tc = tt < 0 ? 0 : tt; const float xl = bf1(F_P[(size_t)tc * PLD + col]); xv[j] = tt < 0 ? 0.f : xl; }
            float y[8];
#pragma unroll
            for (int i = 0; i < 8; ++i) y[i] = silu_f(w0 * xv[i] + w1 * xv[i + 1] + w2 * xv[i + 2] + w3 * xv[i + 3]);
            if (sgi == 0) {
#pragma unroll
                for (int i = 0; i < 8; ++i) yq[i] = y[i];
            } else if (sgi == 1) {
#pragma unroll
                for (int i = 0; i < 8; ++i) yk[i] = y[i];
            } else {
#pragma unroll
                for (int i = 0; i < 8; ++i) y[i] *= bts[tb + i];
                v4u o; o.x = cvtpk(y[0], y[1]); o.y = cvtpk(y[2], y[3]); o.z = cvtpk(y[4], y[5]); o.w = cvtpk(y[6], y[7]); *(LAS v4u*)(L + L_VT + d * 144 + tb * 2) = o;
            }
            asm volatile("" ::: "memory");
        }
#pragma unroll
        for (int i = 0; i < 8; ++i) { const float sq_ = wave_sum(yq[i] * yq[i]), sk_ = wave_sum(yk[i] * yk[i]);
            if (lane == 0) { ssq[((w & 1) * 2 + 0) * 64 + tb + i] = sq_; ssq[((w & 1) * 2 + 1) * 64 + tb + i] = sk_; } }
        LDSW(); wg_sync();
        float kg[8], kd[8];
#pragma unroll
        for (int i = 0; i < 8; ++i) { const int t = tb + i;
            const float rnq = 0.08838834764831845f / sqrtf(ssq[t] + ssq[128 + t] + EPSF), rnk = 1.f / sqrtf(ssq[64 + t] + ssq[192 + t] + EPSF);
            const float bt = bts[t], gc = gcs[t], kk = yk[i] * rnk;
            *(LAS unsigned short*)(L + L_QB + t * 272 + d * 2) = (unsigned short)cvtpk(yq[i] * rnq, 0.f);
            *(LAS unsigned short*)(L + L_KB + t * 272 + d * 2) = (unsigned short)cvtpk(kk, 0.f);
            *(LAS unsigned short*)(L + L_KT + t * 272 + d * 2) = (unsigned short)cvtpk(kk * bt, 0.f);
            kg[i] = kk * bt * __expf(gc); kd[i] = kk * __expf(gl - gc); }
        v4u o; o.x = cvtpk(kg[0], kg[1]); o.y = cvtpk(kg[2], kg[3]); o.z = cvtpk(kg[4], kg[5]); o.w = cvtpk(kg[6], kg[7]); *(LAS v4u*)(L + L_GT + d * 144 + tb * 2) = o;
        o.x = cvtpk(kd[0], kd[1]); o.y = cvtpk(kd[2], kd[3]); o.z = cvtpk(kd[4], kd[5]); o.w = cvtpk(kd[6], kd[7]); *(LAS v4u*)(L + L_DT + d * 144 + tb * 2) = o;
    }
    LDSW(); wg_sync();
    { const int which = w >> 2, it = w & 3; const int i = 16 * it + r; const float gi = gcs[i];
      for (int jt = 0; jt < 4; ++jt) { f32x4 acc = (f32x4){0.f, 0.f, 0.f, 0.f};
          if (jt <= it) acc = tile16(L + L_KB + 16 * jt * 272, 272, L + (which ? L_QB : L_KT) + 16 * it * 272, 272, 4, acc, r, q);
          float v[4];
#pragma unroll
          for (int j = 0; j < 4; ++j) { const int jc = 16 * jt + 4 * q + j; const bool keep = which ? (i >= jc) : (i > jc); v[j] = keep ? acc[j] * __expf(gi - gcs[jc]) : 0.f; }
          if (which) { u32x2 o; o.x = cvtpk(v[0], v[1]); o.y = cvtpk(v[2], v[3]); *(LAS u32x2*)(L + L_AI + i * 144 + (16 * jt + 4 * q) * 2) = o; }
          else *(LAS f32x4*)(AF + i * 68 + 16 * jt + 4 * q) = (f32x4){v[0], v[1], v[2], v[3]}; } }
    LDSW(); wg_sync();
    if (w == 0) { const int b = lane >> 4, c = lane & 15; float tt[16];
#pragma unroll
        for (int i = 0; i < 16; ++i) { float v = (i == c) ? 1.f : 0.f;
#pragma unroll
            for (int j = 0; j < i; ++j) v -= AF[(16 * b + i) * 68 + 16 * b + j] * tt[j];
            tt[i] = v; TF[(16 * b + i) * 68 + 16 * b + c] = v; asm volatile("" ::: "memory"); } }
    LDSW(); wg_sync();
    for (int Lv = 1; Lv < 4; ++Lv) { const int np_ = 4 - Lv;
        for (int o = tid; o < np_ * 256; o += 512) { const int p = o >> 8, rr = (o >> 4) & 15, cc = o & 15, bj = p, bi = p + Lv; float s = 0.f;
            for (int m = 16 * bj; m < 16 * bi; ++m) s += AF[(16 * bi + rr) * 68 + m] * TF[m * 68 + 16 * bj + cc];
            SS[o] = s; }
        LDSW(); wg_sync();
        for (int o = tid; o < np_ * 256; o += 512) { const int p = o >> 8, rr = (o >> 4) & 15, cc = o & 15, bj = p, bi = p + Lv; float s = 0.f;
#pragma unroll
            for (int m = 0; m < 16; ++m) s += TF[(16 * bi + rr) * 68 + 16 * bi + m] * SS[p * 256 + m * 16 + cc];
            TF[(16 * bi + rr) * 68 + 16 * bj + cc] = -s; }
        LDSW(); wg_sync(); }
    for (int o = tid; o < 2048; o += 512) { const int i = o >> 5, j2 = (o & 31) * 2; if ((j2 >> 4) <= (i >> 4)) *(LAS unsigned*)(L + L_TB + i * 144 + j2 * 2) = cvtpk(TF[i * 68 + j2], TF[i * 68 + j2 + 1]); }
    LDSW(); wg_sync();
    { const int which = w >> 2, it = w & 3; f32x4 acc[8];
#pragma unroll
      for (int dt = 0; dt < 8; ++dt) { acc[dt] = (f32x4){0.f, 0.f, 0.f, 0.f}; acc[dt] = tile16(L + L_TB + 16 * it * 144, 144, L + (which ? L_GT : L_VT) + 16 * dt * 144, 144, 2, acc[dt], r, q); }
      LDSW(); wg_sync();
#pragma unroll
      for (int dt = 0; dt < 8; ++dt) { u32x2 o; o.x = cvtpk(acc[dt][0], acc[dt][1]); o.y = cvtpk(acc[dt][2], acc[dt][3]);
#if defined(DBG_O) && DBG_O == 1
          if (which)
#endif
          *(LAS u32x2*)(L + (which ? L_GT : L_VT) + (16 * dt + r) * 144 + (16 * it + 4 * q) * 2) = o; } }
    LDSW(); wg_sync();
    { bf16* Ap = F_AP + (size_t)item * 16384; bf16* BnT = F_BNT + (size_t)item * 16384; bf16* Qe = F_QEFF + (size_t)item * 8192; bf16* Oi = F_OIN + (size_t)item * 8192;
#pragma unroll
      for (int d2t = 0; d2t < 8; ++d2t) { f32x4 acc = (f32x4){0.f, 0.f, 0.f, 0.f}; acc = tile16(L + L_GT + 16 * d2t * 144, 144, L + L_DT + 16 * w * 144, 144, 2, acc, r, q);
          u32x2 o; o.x = cvtpk(-acc[0], -acc[1]); o.y = cvtpk(-acc[2], -acc[3]); *(GAS u32x2*)(Ap + (16 * w + r) * 128 + 16 * d2t + 4 * q) = o; }
#pragma unroll
      for (int d1t = 0; d1t < 8; ++d1t) { f32x4 acc = (f32x4){0.f, 0.f, 0.f, 0.f}; acc = tile16(L + L_DT + 16 * d1t * 144, 144, L + L_VT + 16 * w * 144, 144, 2, acc, r, q);
          u32x2 o; o.x = cvtpk(acc[0], acc[1]); o.y = cvtpk(acc[2], acc[3]); *(GAS u32x2*)(BnT + (16 * w + r) * 128 + 16 * d1t + 4 * q) = o; }
      { const int it = w & 3, dh = w >> 2, i = 16 * it + r; const float eg = __expf(gcs[i]);
#pragma unroll
        for (int dd = 0; dd < 4; ++dd) { const int dt = 4 * dh + dd, dc = 16 * dt + 4 * q;
            f32x4 a1 = (f32x4){0.f, 0.f, 0.f, 0.f}, a2 = a1;
            a1 = tile16(L + L_GT + 16 * dt * 144, 144, L + L_AI + 16 * it * 144, 144, 2, a1, r, q);
            a2 = tile16(L + L_VT + 16 * dt * 144, 144, L + L_AI + 16 * it * 144, 144, 2, a2, r, q);
            const u32x2 qv = *(const LAS u32x2*)(L + L_QB + i * 272 + dc * 2);
            u32x2 o; o.x = cvtpk(bflo(qv.x) * eg - a1[0], bfhi(qv.x) * eg - a1[1]); o.y = cvtpk(bflo(qv.y) * eg - a1[2], bfhi(qv.y) * eg - a1[3]);
            *(GAS u32x2*)(Qe + i * 128 + dc) = o;
#if defined(DBG_O)
            { float vv[4];
#pragma unroll
              for (int j = 0; j < 4; ++j) vv[j] = bf1(*(const LAS unsigned short*)(L + L_VT + (dc + j) * 144 + i * 2));
              a2 = (f32x4){vv[0], vv[1], vv[2], vv[3]}; }
#endif
            o.x = cvtpk(a2[0], a2[1]); o.y = cvtpk(a2[2], a2[3]); *(GAS u32x2*)(Oi + i * 128 + dc) = o; } } }
    wg_sync();
}

DI void scan_head(Frame& F, int h) {
    const int lane = F.lane, w = F.wave, tid = F.tid, r = lane & 15, q = lane >> 4;
    LAS unsigned char* L = F.lds; LAS unsigned char* ST = L + 69632 + w * 4352;
    f32x4 acc[8];
#pragma unroll
    for (int dt = 0; dt < 8; ++dt) acc[dt] = (f32x4){0.f, 0.f, 0.f, 0.f};
    v4u areg[4];
    { const bf16* Ap = F_AP + (size_t)(h * 128) * 16384;
#pragma unroll
      for (int i = 0; i < 4; ++i) areg[i] = *(const GAS v4u*)(Ap + (size_t)(tid + 512 * i) * 8); }
    for (int n = 0; n < 128; ++n) {
        const int item = h * 128 + n; LAS unsigned char* AB_ = L + (n & 1) * 34816;
#pragma unroll
        for (int i = 0; i < 4; ++i) { const int c = tid + 512 * i; *(LAS v4u*)(AB_ + (c >> 4) * 272 + (c & 15) * 16) = areg[i]; }
        if (n + 1 < 128) { const bf16* Ap = F_AP + (size_t)(item + 1) * 16384;
#pragma unroll
            for (int i = 0; i < 4; ++i) areg[i] = *(const GAS v4u*)(Ap + (size_t)(tid + 512 * i) * 8); }
        const float eg = F_GLX[item];
        u32x2 bn[8];
        { const bf16* BnT = F_BNT + (size_t)item * 16384 + (16 * w + r) * 128 + 4 * q;
#pragma unroll
          for (int dt = 0; dt < 8; ++dt) bn[dt] = *(const GAS u32x2*)(BnT + 16 * dt); }
        { bf16* Sg = F_SG + (size_t)item * 16384 + (16 * w + r) * 128 + 4 * q;
#pragma unroll
          for (int dt = 0; dt < 8; ++dt) { u32x2 o; o.x = cvtpk(acc[dt][0], acc[dt][1]); o.y = cvtpk(acc[dt][2], acc[dt][3]);
              *(LAS u32x2*)(ST + r * 272 + (16 * dt + 4 * q) * 2) = o; *(GAS u32x2*)(Sg + 16 * dt) = o; } }
        LDSW(); __builtin_amdgcn_s_barrier(); asm volatile("" ::: "memory");
#pragma unroll
        for (int dt = 0; dt < 8; ++dt) { f32x4 c;
            c[0] = acc[dt][0] * eg + bflo(bn[dt].x); c[1] = acc[dt][1] * eg + bfhi(bn[dt].x); c[2] = acc[dt][2] * eg + bflo(bn[dt].y); c[3] = acc[dt][3] * eg + bfhi(bn[dt].y);
            acc[dt] = tile16(AB_ + 16 * dt * 272, 272, ST, 272, 4, c, r, q); }
    }
    LDSW(); wg_sync();
}

DI void dnout_item(Frame& F, int item, int wi) {
    const int h = item >> 7, n = item & 127, lane = F.lane, r = lane & 15, q = lane >> 4;
    const int i = 16 * wi + r, t = 64 * n + i;
    const bf16* Qe = F_QEFF + (size_t)item * 8192 + i * 128 + 8 * q; const bf16* Sg = F_SG + (size_t)item * 16384 + r * 128 + 8 * q;
    bf16x8 bq[4];
#pragma unroll
    for (int ks = 0; ks < 4; ++ks) bq[ks] = *(const GAS bf16x8*)(Qe + 32 * ks);
    f32x4 o[8]; float ss = 0.f;
    const bf16* Oi = F_OIN + (size_t)item * 8192 + i * 128 + 4 * q;
#pragma unroll
    for (int dt = 0; dt < 8; ++dt) { const u32x2 oi = *(const GAS u32x2*)(Oi + 16 * dt); f32x4 c = (f32x4){bflo(oi.x), bfhi(oi.x), bflo(oi.y), bfhi(oi.y)};
#if !defined(DBG_NOSTATE)
#pragma unroll
        for (int ks = 0; ks < 4; ++ks) { const bf16x8 a = *(const GAS bf16x8*)(Sg + (size_t)(16 * dt) * 128 + 32 * ks); c = MFMA16(a, bq[ks], c); }
#endif
        o[dt] = c; ss += (c[0] * c[0] + c[1] * c[1]) + (c[2] * c[2] + c[3] * c[3]); }
    ss += __shfl_xor(ss, 16); ss += __shfl_xor(ss, 32);
    const float rs = 1.f / sqrtf(ss * (1.f / 128.f) + EPSF);
    const bf16* zrow = F_P + (size_t)t * PLD + PC_DZ + 128 * h + 4 * q; bf16* orow = F_MIXED + (size_t)t * DM + MC_B + 128 * h + 4 * q;
#pragma unroll
    for (int dt = 0; dt < 8; ++dt) { const u32x2 z = *(const GAS u32x2*)(zrow + 16 * dt); const f32x4 gg = *(const GAS f32x4*)(F_dn_g + 16 * dt + 4 * q);
        u32x2 ov; ov.x = cvtpk(o[dt][0] * rs * gg[0] * silu_f(bflo(z.x)), o[dt][1] * rs * gg[1] * silu_f(bfhi(z.x)));
        ov.y = cvtpk(o[dt][2] * rs * gg[2] * silu_f(bflo(z.y)), o[dt][3] * rs * gg[3] * silu_f(bfhi(z.y)));
        *(GAS u32x2*)(orow + 16 * dt) = ov; }
}
DI void final_row(float* row, const float* g, int lane) {
    GAS f32x4* xr = (GAS f32x4*)row + lane; f32x4 v[8]; float s = 0.f;
#pragma unroll
    for (int j = 0; j < 8; ++j) { v[j] = xr[64 * j]; s += (v[j].x * v[j].x + v[j].y * v[j].y) + (v[j].z * v[j].z + v[j].w * v[j].w); }
    const float rs = 1.f / sqrtf(wave_sum(s) * (1.f / DM) + EPSF);
#pragma unroll
    for (int j = 0; j < 8; ++j) { const f32x4 gg = ((const GAS f32x4*)g)[64 * j + lane]; xr[64 * j] = v[j] * rs * gg; }
}
struct Args { const float* in[16]; float* out; unsigned char* ws; int ph_lo, ph_hi, li, pad; };
__global__ void __launch_bounds__(NWAVES * 64, 2) fwd_kernel(Args args) {
    extern __shared__ __attribute__((aligned(16))) unsigned char lds[];
    Frame F;
    F.lds = (LAS unsigned char*)lds; F.MISC = (volatile LAS unsigned*)(F.lds + MISC_OFF);
    F.tid = threadIdx.x; F.lane = F.tid & 63; F.wave = __builtin_amdgcn_readfirstlane(F.tid >> 6);
    F.G = gridDim.x; { const int bx = blockIdx.x; F.vcu = (F.G % 8 == 0) ? (bx % 8) * (F.G / 8) + bx / 8 : bx; }
    F.ws = args.ws; F.out = args.out;
    F.inp = (const float* const*)__builtin_amdgcn_kernarg_segment_ptr();
    for (int u = F.tid; u < (LDS_BYTES - LDSCTL_OFF) / 4; u += NWAVES * 64) ((LAS unsigned*)(F.lds + LDSCTL_OFF))[u] = 0u;
    __syncthreads();
    XcdBarrier bar; bar.bar = (unsigned*)(F_ctl + CW_BAR); bar.x = 0; bar.st = nullptr;
    if (N_LAUNCHES == 1) bar = xcd_barrier_post((unsigned*)(F_ctl + CW_BAR), F.MISC + 8);
#define GRID_BAR() do { if (N_LAUNCHES == 1) xcd_barrier(bar); } while (0)
    const int lo = args.ph_lo, hi = args.ph_hi;
#ifndef ITEM_MASK
#define ITEM_MASK 7
#endif
#ifndef PH_MASK
#define PH_MASK 0x7f
#endif
#define IN(k) (((PH_MASK >> (k)) & 1) && lo <= (k) && (k) < hi)
#define BOTH(k) (IN(k) && IN((k) + 1))
#define REFRESH() do { int t_ = threadIdx.x; asm volatile("" : "+v"(t_)); F.tid = t_; F.lane = t_ & 63; } while (0)
    if (IN(0)) { REFRESH(); p0_prologue(F); if (BOTH(0)) GRID_BAR(); }
    if (IN(1)) {
        pg8::Gemm g{F_XB, F_WTIN, SEQ + NMEMT, NPADC + 1024, DM}; pg8::Order1 S; S.init(F.G, (int)blockIdx.x);
        pg8::EpiProj E{F_P, F_AB, F_RSTD, F_MKV};
        pg8::gemm_phase<pg8::EpiProj, pg8::Order1, true, true>(F.lds, g, S, E);
        if (BOTH(1)) GRID_BAR();
    }
    if (IN(2)) {
        REFRESH();
        if (ITEM_MASK & 1) for (int it = F.vcu; it < 1024; it += F.G) dnprep_item(F, it);
        if (ITEM_MASK & 2) for (int it = F.vcu; it < 256; it += F.G) gmlp_item(F, it);
        if (ITEM_MASK & 4) for (int it = F.vcu; it < 256; it += F.G) xattn_item(F, it);
        if (BOTH(2)) GRID_BAR();
    }
    if (IN(3)) { REFRESH(); if (blockIdx.x < 8) scan_head(F, (int)blockIdx.x); if (BOTH(3)) GRID_BAR(); }
    if (IN(4)) { REFRESH(); for (int it = (int)blockIdx.x * 2 + (F.wave >> 2); it < 1024; it += 2 * F.G) dnout_item(F, it, F.wave & 3); if (BOTH(4)) GRID_BAR(); }
    if (IN(5)) {
        pg8::Gemm g{F_MIXED, F_WTOUT, SEQ, DM, DM}; pg8::StaticOrder S; S.init(SEQ, DM, F.G, (int)blockIdx.x);
        pg8::EpiRes E{F_x, F.out};
        pg8::gemm_phase<pg8::EpiRes, pg8::StaticOrder, true, true>(F.lds, g, S, E);
        if (BOTH(5)) GRID_BAR();
    }
    if (IN(6)) { REFRESH(); const int gw = F.vcu * NWAVES + F.wave, NGW = F.G * NWAVES; for (int m = gw; m < SEQ; m += NGW) final_row(F.out + (size_t)m * DM, F_final_g, F.lane); }
#undef IN
#undef BOTH
}

extern "C" void kernel_launch(void* const* d_in, const int* in_sizes, int n_in, void* d_out, int out_size, void* d_ws, size_t ws_size, hipStream_t stream) {
    static int grid = 0;
    if (grid == 0) {
        if (n_in != 16 || in_sizes[0] != SEQ * DM || out_size != SEQ * DM || ws_size < WS_END) { fprintf(stderr, "kernel_launch: unexpected shapes (n_in %d, in0 %d, out %d, ws %zu); nothing launched\n", n_in, n_in > 0 ? in_sizes[0] : -1, out_size, ws_size); grid = -1; return; }
        int dev = 0, cus = 0, per_cu = 0;
        if (hipGetDevice(&dev) != hipSuccess || hipDeviceGetAttribute(&cus, hipDeviceAttributeMultiprocessorCount, dev) != hipSuccess) { grid = -1; return; }
        if (hipFuncSetAttribute((const void*)fwd_kernel, hipFuncAttributeMaxDynamicSharedMemorySize, LDS_BYTES) != hipSuccess) { fprintf(stderr, "kernel_launch: hipFuncSetAttribute failed\n"); grid = -1; return; }
        if (hipOccupancyMaxActiveBlocksPerMultiprocessor(&per_cu, (const void*)fwd_kernel, NWAVES * 64, LDS_BYTES) != hipSuccess || per_cu < 1) fprintf(stderr, "kernel_launch: note: occupancy query reports %d\n", per_cu);
        (void)hipGetLastError();
        grid = cus;
    }
    if (grid < 0) return;
    if (hipMemsetAsync((char*)d_ws + WS_CTL, 0, CTL_ZERO_BYTES, stream) != hipSuccess) return;
    Args a{};
    for (int i = 0; i < 16; ++i) a.in[i] = (const float*)d_in[i];
    a.out = (float*)d_out; a.ws = (unsigned char*)d_ws;
    for (int li = 0; li < N_LAUNCHES; ++li) {
        a.ph_lo = (N_LAUNCHES == 1) ? 0 : li; a.ph_hi = (N_LAUNCHES == 1) ? N_PHASES : li + 1; a.li = li;
        hipLaunchKernelGGL(fwd_kernel, dim3(grid), dim3(NWAVES * 64), LDS_BYTES, stream, a);
        if (hipPeekAtLastError() != hipSuccess) { fprintf(stderr, "kernel_launch: launch %d failed\n", li); break; }
    }
}
```

```cpp
#include <hip/hip_runtime.h>
#include <cstdio>
#include <cstdint>
#ifndef MK_N_LAUNCHES
#define MK_N_LAUNCHES 1
#endif
namespace pg8 {
#define PG8_LAS __attribute__((address_space(3)))
typedef unsigned short bf16_t;
typedef short bf16x8 __attribute__((ext_vector_type(8)));
typedef float f32x4 __attribute__((ext_vector_type(4)));
typedef unsigned u32x4 __attribute__((ext_vector_type(4)));
constexpr int BM = 256, BK = 64, HALF = 128, HTB = HALF * BK * 2  , STAGE_BYTES = 8 * HTB, NXCD = 8, WGM = 8;

__host__ __device__ __forceinline__ int lds_byte(int r, int c) { const int st = (r >> 4) * 2 + (c >> 5), rr = r & 15, cc = c & 31, ob = rr * 64 + cc * 2; return st * 1024 + (ob ^ (((ob >> 9) & 1) << 5)); }
__host__ __device__ __forceinline__ void stage_rc(int b, int& R, int& C) { const int st = b / 1024, sb = b % 1024, swz = sb ^ (((sb >> 9) & 1) << 5); R = (st >> 1) * 16 + swz / 64; C = (st & 1) * 32 + (swz % 64) / 2; }
__host__ __device__ __forceinline__ int perm32(int rho) { const int n = rho >> 4, i = rho & 15; return 8 * (i >> 2) + 4 * n + (i & 3); }

struct Unit { int pm, pn; };
struct Gemm { const bf16_t* A; const bf16_t* Bt; int M, N, K; };

struct StaticOrder {
    int nM, nN, nwg, G, c;
    __host__ __device__ void init(int M, int N, int G_, int c_) { nM = M / BM; nN = N / BM; nwg = nM * nN; G = G_; c = c_; }
    __host__ __device__ bool next(int i, Unit& u) const {
        const long L = (long)i * G + c; if (L >= nwg) return false;
        int wgid = (int)L; { const int q = nwg / NXCD, r = nwg % NXCD, xcd = wgid % NXCD, off = wgid / NXCD; wgid = (xcd < r ? xcd * (q + 1) : r * (q + 1) + (xcd - r) * q) + off; }
        const int nig = WGM * nN, gid = wgid / nig, fm = gid * WGM, gsz = (nM - fm) < WGM ? (nM - fm) : WGM;
        u.pm = fm + ((wgid % nig) % gsz); u.pn = (wgid % nig) / gsz; return true;
    }
    __device__ __forceinline__ void a_ready(const Unit&) const {}
    __device__ __forceinline__ void done(const Unit&) const {}
};

__device__ __forceinline__ unsigned cvt_pk_bf16(float lo, float hi) { unsigned r; asm volatile("v_cvt_pk_bf16_f32 %0, %1, %2" : "=v"(r) : "v"(lo), "v"(hi)); return r; }
struct EpiProj {
    static constexpr bool PERM = true, AFTER_DRAIN = false;
    bf16_t* P; float* AB; const float* rstd; bf16_t* MKV;
    __device__ __forceinline__ void operator()(const f32x4 (&acc)[2][2][4][2], const Unit& u, int wr, int wc, int fr, int fq) const {
        const int row0 = wr * 64 + fr; const bool memt = u.pm >= 32;
        const float* rsp = rstd + (memt ? 0 : u.pm * BM);
        if (u.pn != 26) {
            bf16_t* base = memt ? MKV + (size_t)(u.pn - 27) * BM : P + (size_t)u.pm * BM * 6656 + (size_t)u.pn * BM; const int ldc = memt ? 1024 : 6656;
            base += wc * 32 + 8 * fq;
#pragma unroll
            for (int ai = 0; ai < 2; ++ai)
#pragma unroll
                for (int m = 0; m < 4; ++m) { const int row = row0 + ai * HALF + m * 16; const float rs = memt ? 1.f : rsp[row]; bf16_t* rowp = base + (size_t)row * ldc;
#pragma unroll
                    for (int bj = 0; bj < 2; ++bj) { const f32x4 v0 = acc[ai][bj][m][0] * rs, v1 = acc[ai][bj][m][1] * rs;
                        u32x4 w; w.x = cvt_pk_bf16(v0[0], v0[1]); w.y = cvt_pk_bf16(v0[2], v0[3]); w.z = cvt_pk_bf16(v1[0], v1[1]); w.w = cvt_pk_bf16(v1[2], v1[3]);
                        *(u32x4*)(rowp + bj * HALF) = w; } }
        } else if (wc == 0 && fq < 2) {
#pragma unroll
            for (int ai = 0; ai < 2; ++ai)
#pragma unroll
                for (int m = 0; m < 4; ++m) { const int row = row0 + ai * HALF + m * 16; const float rs = rsp[row];
#pragma unroll
                    for (int n = 0; n < 2; ++n) *(f32x4*)(AB + (size_t)(u.pm * BM + row) * 16 + 8 * fq + 4 * n) = acc[ai][0][m][n] * rs; }
        }
    }
};
struct EpiRes {
    static constexpr bool PERM = false, AFTER_DRAIN = false;
    const float* X; float* O;
    __device__ __forceinline__ void operator()(const f32x4 (&acc)[2][2][4][2], const Unit& u, int wr, int wc, int fr, int fq) const {
        const int row0 = u.pm * BM + wr * 64 + fr, col0 = u.pn * BM + wc * 32 + 4 * fq;
#pragma unroll
        for (int ai = 0; ai < 2; ++ai)
#pragma unroll
            for (int m = 0; m < 4; ++m) { const size_t off = (size_t)(row0 + ai * HALF + m * 16) * 2048 + col0;
#pragma unroll
                for (int bj = 0; bj < 2; ++bj)
#pragma unroll
                    for (int n = 0; n < 2; ++n) { const f32x4 xv = *(const f32x4*)(X + off + bj * HALF + n * 16); *(f32x4*)(O + off + bj * HALF + n * 16) = xv + acc[ai][bj][m][n]; } }
    }
};
struct Order1 {
    StaticOrder so; int G, c;
    __device__ void init(int G_, int c_) { so.init(8192, 6912, G_, c_); G = G_; c = c_; }
    __device__ bool next(int i, Unit& u) const { const long L = (long)i * G + c; if (L < 864) return so.next(i, u); if (L < 868) { u.pm = 32; u.pn = 27 + (int)(L - 864); return true; } return false; }
    __device__ __forceinline__ void a_ready(const Unit&) const {}
    __device__ __forceinline__ void done(const Unit&) const {}
};
template <class Epi, class Sched, bool ALIGN_EPI = false, bool SP2 = false>
__device__ __forceinline__ void gemm_phase(PG8_LAS unsigned char* lds, const Gemm g, const Sched& S, const Epi& E) {
    const int tid = threadIdx.x, wid = __builtin_amdgcn_readfirstlane(tid >> 6), lane = tid & 63, wr = wid >> 2, wc = wid & 3, fr = lane & 15, fq = lane >> 4;
    const int K = g.K, nt = K / BK;
    unsigned voffA[2], voffB[2];
#pragma unroll
    for (int i = 0; i < 2; ++i) { int R, C; stage_rc(tid * 16 + i * 8192, R, C); const int Rb = Epi::PERM ? ((R & ~31) + perm32(R & 31)) : R;
        voffA[i] = (unsigned)(R * K + C) * 2u; voffB[i] = (unsigned)(Rb * K + C) * 2u; }
    const size_t kstep = (size_t)(BK * 2);
    const size_t hstep = (size_t)HALF * K * 2;
    const size_t tstep = 2 * hstep;
    const unsigned ldsw = (unsigned)wid * 1024u;
    const int aoff = lds_byte(wr * 64 + fr, fq * 8), boff = lds_byte(wc * 32 + fr, fq * 8);
#define PG8_SA(b, h) (((b) * 2 + (h)) * HTB)
#define PG8_SB(b, h) ((4 + (b) * 2 + (h)) * HTB)
#define PG8_STAGE(bufoff, gbase, voff) do { _Pragma("unroll") for (int _i = 0; _i < 2; ++_i) \
        __builtin_amdgcn_global_load_lds((const unsigned*)((const char*)(gbase) + (voff)[_i]), (PG8_LAS unsigned*)(lds + (bufoff) + ldsw + _i * 8192), 16, 0, 0); } while (0)
#define PG8_LDA(dst, b, h) do { _Pragma("unroll") for (int m = 0; m < 4; ++m) _Pragma("unroll") for (int k = 0; k < 2; ++k) dst[m][k] = *(const PG8_LAS bf16x8*)(lds + PG8_SA(b, h) + aoff + m * 2048 + k * 1024); } while (0)
#define PG8_LDB(dst, b, h) do { _Pragma("unroll") for (int n = 0; n < 2; ++n) _Pragma("unroll") for (int k = 0; k < 2; ++k) dst[n][k] = *(const PG8_LAS bf16x8*)(lds + PG8_SB(b, h) + boff + n * 2048 + k * 1024); } while (0)
#define PG8_MMA(ai, bj, At, Bt) do { __builtin_amdgcn_s_setprio(1); _Pragma("unroll") for (int m = 0; m < 4; ++m) _Pragma("unroll") for (int n = 0; n < 2; ++n) _Pragma("unroll") for (int k = 0; k < 2; ++k) \
        acc[ai][bj][m][n] = __builtin_amdgcn_mfma_f32_16x16x32_bf16(Bt[n][k], At[m][k], acc[ai][bj][m][n], 0, 0, 0); __builtin_amdgcn_s_setprio(0); } while (0)
#define PG8_WAIT_V(n) asm volatile("s_waitcnt vmcnt(" #n ")" ::: "memory")
#define PG8_WAIT_L(n) asm volatile("s_waitcnt lgkmcnt(" #n ")" ::: "memory")
#define PG8_BAR __builtin_amdgcn_s_barrier()
#define PG8_SCHED __builtin_amdgcn_sched_barrier(0)
    Unit cur, nxt; int ui = 0;
    if (!S.next(0, cur)) return;
    f32x4 acc[2][2][4][2];
#pragma unroll
    for (int a = 0; a < 2; ++a)
#pragma unroll
        for (int b = 0; b < 2; ++b)
#pragma unroll
            for (int m = 0; m < 4; ++m)
#pragma unroll
                for (int n = 0; n < 2; ++n) acc[a][b][m][n] = (f32x4){0.f, 0.f, 0.f, 0.f};
    bf16x8 At[4][2], B0[2][2], B1[2][2];
    const char* cA = (const char*)g.A + (size_t)cur.pm * tstep; const char* cB = (const char*)g.Bt + (size_t)cur.pn * tstep;
    S.a_ready(cur);
    if constexpr (SP2) {
        PG8_STAGE(PG8_SB(0, 0), cB, voffB); PG8_STAGE(PG8_SB(0, 1), cB + hstep, voffB); PG8_STAGE(PG8_SA(0, 0), cA, voffA); PG8_STAGE(PG8_SA(0, 1), cA + hstep, voffA);
        if (wr == 1) PG8_BAR;
        PG8_WAIT_V(2); PG8_BAR;
        PG8_STAGE(PG8_SB(1, 0), cB + kstep, voffB); PG8_STAGE(PG8_SA(1, 0), cA + kstep, voffA); PG8_STAGE(PG8_SB(1, 1), cB + hstep + kstep, voffB);
        PG8_WAIT_V(6); PG8_BAR;
    } else {
        PG8_STAGE(PG8_SB(0, 0), cB, voffB); PG8_STAGE(PG8_SA(0, 0), cA, voffA); PG8_STAGE(PG8_SB(0, 1), cB + hstep, voffB); PG8_STAGE(PG8_SA(0, 1), cA + hstep, voffA);
        if (wr == 1) PG8_BAR;
        PG8_WAIT_V(4); PG8_BAR;
        PG8_STAGE(PG8_SB(1, 0), cB + kstep, voffB); PG8_STAGE(PG8_SA(1, 0), cA + kstep, voffA); PG8_STAGE(PG8_SB(1, 1), cB + hstep + kstep, voffB);
        PG8_WAIT_V(6); PG8_BAR;
    }
    for (;;) {
        const bool has_next = S.next(ui + 1, nxt);
        const char* nA = has_next ? (const char*)g.A + (size_t)nxt.pm * tstep : cA; const char* nB = has_next ? (const char*)g.Bt + (size_t)nxt.pn * tstep : cB;
        for (int t = 0; t < nt; t += 2) {
            const bool last = (t == nt - 2);
            const char* a1 = cA + (size_t)(t + 1) * kstep;
            const char* a2 = last ? nA : cA + (size_t)(t + 2) * kstep; const char* b2 = last ? nB : cB + (size_t)(t + 2) * kstep;
            const char* a3 = a2 + kstep; const char* b3 = b2 + kstep;
            if (last && has_next) S.a_ready(nxt);
            if constexpr (SP2) {
            PG8_LDB(B0, 0, 0); PG8_LDB(B1, 0, 1); PG8_SCHED; PG8_LDA(At, 0, 0); PG8_STAGE(PG8_SA(1, 1), a1 + hstep, voffA);
            PG8_WAIT_V(8); PG8_WAIT_L(0); PG8_BAR; PG8_MMA(0, 0, At, B0); PG8_MMA(0, 1, At, B1); PG8_BAR; PG8_SCHED;
            PG8_LDA(At, 0, 1); PG8_STAGE(PG8_SB(0, 0), b2, voffB); PG8_STAGE(PG8_SB(0, 1), b2 + hstep, voffB); PG8_STAGE(PG8_SA(0, 0), a2, voffA);
            PG8_WAIT_V(8); PG8_WAIT_L(0); PG8_BAR; PG8_MMA(1, 0, At, B0); PG8_MMA(1, 1, At, B1); PG8_BAR; PG8_SCHED;
            PG8_LDB(B0, 1, 0); PG8_LDB(B1, 1, 1); PG8_SCHED; PG8_LDA(At, 1, 0); PG8_STAGE(PG8_SA(0, 1), a2 + hstep, voffA);
            PG8_WAIT_V(8); PG8_WAIT_L(0); PG8_BAR; PG8_MMA(0, 0, At, B0); PG8_MMA(0, 1, At, B1); PG8_BAR; PG8_SCHED;
            PG8_LDA(At, 1, 1); PG8_STAGE(PG8_SB(1, 0), b3, voffB); PG8_STAGE(PG8_SB(1, 1), b3 + hstep, voffB); PG8_STAGE(PG8_SA(1, 0), a3, voffA);
            PG8_WAIT_V(8); PG8_WAIT_L(0); PG8_BAR; PG8_MMA(1, 0, At, B0); PG8_MMA(1, 1, At, B1); PG8_BAR; PG8_SCHED;
            } else {
            PG8_LDB(B0, 0, 0); PG8_SCHED; PG8_LDA(At, 0, 0); PG8_STAGE(PG8_SA(1, 1), a1 + hstep, voffA);
            PG8_WAIT_L(8); PG8_BAR; PG8_WAIT_L(0); PG8_MMA(0, 0, At, B0); PG8_BAR; PG8_SCHED;
            PG8_LDB(B1, 0, 1); PG8_STAGE(PG8_SB(0, 0), b2, voffB);
            PG8_BAR; PG8_WAIT_L(0); PG8_MMA(0, 1, At, B1); PG8_BAR;
            PG8_LDA(At, 0, 1); PG8_STAGE(PG8_SA(0, 0), a2, voffA);
            PG8_BAR; PG8_WAIT_L(0); PG8_MMA(1, 0, At, B0); PG8_BAR; PG8_SCHED;
            PG8_STAGE(PG8_SB(0, 1), b2 + hstep, voffB);
            PG8_WAIT_V(6); PG8_BAR; PG8_MMA(1, 1, At, B1); PG8_BAR;
            PG8_LDB(B0, 1, 0); PG8_SCHED; PG8_LDA(At, 1, 0); PG8_STAGE(PG8_SA(0, 1), a2 + hstep, voffA);
            PG8_WAIT_L(8); PG8_BAR; PG8_WAIT_L(0); PG8_MMA(0, 0, At, B0); PG8_BAR; PG8_SCHED;
            PG8_LDB(B1, 1, 1); PG8_STAGE(PG8_SB(1, 0), b3, voffB);
            PG8_BAR; PG8_WAIT_L(0); PG8_MMA(0, 1, At, B1); PG8_BAR;
            PG8_LDA(At, 1, 1); PG8_STAGE(PG8_SA(1, 0), a3, voffA);
            PG8_BAR; PG8_WAIT_L(0); PG8_MMA(1, 0, At, B0); PG8_BAR; PG8_SCHED;
            PG8_STAGE(PG8_SB(1, 1), b3 + hstep, voffB);
            PG8_WAIT_V(6); PG8_BAR; PG8_MMA(1, 1, At, B1); PG8_BAR;
            }
        }
        if constexpr (ALIGN_EPI) { if (wr == 0) PG8_BAR; }
        if constexpr (!Epi::AFTER_DRAIN) { E(acc, cur, wr, wc, fr, fq); S.done(cur); }
        if (!has_next) break;
#pragma unroll
        for (int a = 0; a < 2; ++a)
#pragma unroll
            for (int b = 0; b < 2; ++b)
#pragma unroll
                for (int m = 0; m < 4; ++m)
#pragma unroll
                    for (int n = 0; n < 2; ++n) acc[a][b][m][n] = (f32x4){0.f, 0.f, 0.f, 0.f};
        cur = nxt; cA = nA; cB = nB; ++ui;
        if constexpr (ALIGN_EPI) { if (wr == 1) PG8_BAR; }
    }
    PG8_WAIT_V(0);
    if constexpr (!ALIGN_EPI) { if (wr == 0) PG8_BAR; }
    PG8_BAR;
    if constexpr (Epi::AFTER_DRAIN) { E.fused(acc, cur, wr, wc, fr, fq, lds, wid, lane); S.done(cur); }
#undef PG8_SA
#undef PG8_SB
#undef PG8_STAGE
#undef PG8_LDA
#undef PG8_LDB
#undef PG8_MMA
#undef PG8_WAIT_V
#undef PG8_WAIT_L
#undef PG8_BAR
#undef PG8_SCHED
}
}
constexpr int NWAVES = 8;
constexpr int N_LAUNCHES = MK_N_LAUNCHES;
constexpr int N_PHASES = 7;
constexpr int SEQ = 8192, DM = 2048, NIN = 6672, NPADC = 6912, PLD = 6656, NMEMT = 256;
constexpr int PC_GU = 0, PC_GV = 512, PC_GZ = 1024, PC_DQ = 1536, PC_DK = 2560, PC_DV = 3584, PC_DZ = 4608, PC_CQ = 5632, PC_CZ = 6144;
constexpr int MC_A = 0, MC_B = 512, MC_C = 1536;
constexpr float EPSF = 1e-6f;
constexpr size_t MiB = 1u << 20;
constexpr size_t WS_CTL = 0, CTL_ZERO_BYTES = 1 * MiB;
constexpr size_t WS_XB = 2 * MiB;
constexpr size_t WS_WTIN = 36 * MiB;
constexpr size_t WS_WTOUT = 68 * MiB;
constexpr size_t WS_RSTD = 76 * MiB;
constexpr size_t WS_AB = 76 * MiB + 65536;
constexpr size_t WS_GLX = 76 * MiB + 655360;
constexpr size_t WS_MKV = 77 * MiB;
constexpr size_t WS_P = 78 * MiB;
constexpr size_t WS_MIXED = 182 * MiB;
constexpr size_t WS_SG = 214 * MiB;
constexpr size_t WS_END = 246 * MiB;
constexpr size_t WS_AP = 2 * MiB;
constexpr size_t WS_BNT = 34 * MiB;
constexpr size_t OUT_QEFF = 0;
constexpr size_t OUT_OIN = 16 * MiB;
constexpr int CW_TMO = 0, CW_BAR = 4096;
constexpr int LDS_BYTES = 163840;
constexpr int LDSCTL_OFF = 162816, MISC_OFF = LDSCTL_OFF + 320;
#define GAS __attribute__((address_space(1)))
#define LAS __attribute__((address_space(3)))
typedef unsigned short bf16;
typedef unsigned v4u __attribute__((ext_vector_type(4)));
typedef float f32x4 __attribute__((ext_vector_type(4)));
typedef short bf16x8 __attribute__((ext_vector_type(8)));
typedef GAS unsigned gu32;
typedef GAS unsigned long long gu64;
#define RLX_AGENT __ATOMIC_RELAXED, __HIP_MEMORY_SCOPE_AGENT
#define LDS_WAIT() asm volatile("s_waitcnt lgkmcnt(0)" ::: "memory")
#define VM_WAIT() asm volatile("s_waitcnt vmcnt(0)" ::: "memory")
__device__ __forceinline__ unsigned long long rt() { return __builtin_amdgcn_s_memrealtime(); }
__device__ __forceinline__ unsigned f2bf(float f) { unsigned u = __builtin_bit_cast(unsigned, f); return (u + 0x7fffu + ((u >> 16) & 1u)) >> 16; }
__device__ __forceinline__ unsigned pk2(float lo, float hi) { return f2bf(lo) | (f2bf(hi) << 16); }

#define XB_TMO      128
#define XB_XCNT(j)  (256  + 64 * (j))
#define XB_XSUB(j)  (1280 + 64 * (j))
#define XB_XGEN(j)  (2304 + 64 * (j))
#define XB_TOP      3328
#define XB_TOPGEN   3392
#define XCD_BAR_WORDS 3456
#define XB_SPIN_CAP (1u << 18)

__device__ __forceinline__ unsigned xb_ld(unsigned* p)              { return __hip_atomic_load(p, __ATOMIC_RELAXED, __HIP_MEMORY_SCOPE_AGENT); }
__device__ __forceinline__ unsigned xb_add(unsigned* p, unsigned v) { return __hip_atomic_fetch_add(p, v, __ATOMIC_RELAXED, __HIP_MEMORY_SCOPE_AGENT); }
__device__ __forceinline__ unsigned xb_xcc_id() { return (unsigned)__builtin_amdgcn_s_getreg((3 << 11) | 20) & 0xFu; }
#define XB_SPIN(cond, bar) do { unsigned _sp = 0; while (cond) { __builtin_amdgcn_s_sleep(1); \
    if ((++_sp & 255u) == 0u) { if (xb_ld(&(bar)[XB_TMO])) break; if (_sp > XB_SPIN_CAP) { atomicAdd(&(bar)[XB_TMO], 1u); break; } } } } while (0)

struct XcdBarrier {
    unsigned* bar; unsigned x;
    volatile LAS unsigned* st;
};

__device__ __forceinline__ XcdBarrier xcd_barrier_post(unsigned* bar, volatile LAS unsigned* st) {
    XcdBarrier b; b.bar = bar; b.x = xb_xcc_id(); b.st = st;
    if (threadIdx.x == 0) (void)xb_add(&bar[XB_XCNT(b.x)], 1u);
    return b;
}
__device__ __forceinline__ void xcd_barrier_complete(unsigned* bar, unsigned x, unsigned& nloc, unsigned& nx) {
    const unsigned G = gridDim.x * gridDim.y * gridDim.z;
    unsigned sum, cnt, mine, sp = 0u;
    for (;;) {
        sum = 0u; cnt = 0u; mine = 0u;
#pragma unroll
        for (unsigned j = 0; j < 16; ++j) { const unsigned c = xb_ld(&bar[XB_XCNT(j)]); sum += c; cnt += (c > 0u) ? 1u : 0u; mine = (j == x) ? c : mine; }
        if (sum == G) break;
        __builtin_amdgcn_s_sleep(1);
        if ((++sp & 255u) == 0u) { if (xb_ld(&bar[XB_TMO])) break; if (sp > XB_SPIN_CAP) { atomicAdd(&bar[XB_TMO], 1u); break; } }
    }
    nloc = mine > 0u ? mine : 1u; nx = cnt > 0u ? cnt : 1u;
}

__device__ __forceinline__ void xcd_barrier(const XcdBarrier& b) {
    asm volatile("s_waitcnt vmcnt(0)" ::: "memory");
    __syncthreads();
    if (threadIdx.x == 0) {
        unsigned* bar = b.bar;
        __builtin_amdgcn_s_waitcnt(0);
        unsigned nloc = b.st[0], nx = b.st[1];
        if (nloc == 0u) { xcd_barrier_complete(bar, b.x, nloc, nx); b.st[0] = nloc; b.st[1] = nx; }
        const unsigned old = xb_add(&bar[XB_XSUB(b.x)], 1u);
        const unsigned gen = old / nloc;
        if (old + 1u == (gen + 1u) * nloc) {
            __builtin_amdgcn_fence(__ATOMIC_RELEASE, "agent");
            asm volatile("s_waitcnt vmcnt(0)" ::: "memory");
            const unsigned og = xb_add(&bar[XB_TOP], 1u);
            const unsigned tg = og / nx;
            if (og + 1u == (tg + 1u) * nx) xb_add(&bar[XB_TOPGEN], 1u);
            else XB_SPIN(xb_ld(&bar[XB_TOPGEN]) == tg, bar);
            __builtin_amdgcn_fence(__ATOMIC_ACQUIRE, "agent");
            xb_add(&bar[XB_XGEN(b.x)], 1u);
            asm volatile("s_waitcnt vmcnt(0)" ::: "memory");
        } else {
            XB_SPIN(xb_ld(&bar[XB_XGEN(b.x)]) == gen, bar);
            __builtin_amdgcn_fence(__ATOMIC_ACQUIRE, "agent");
            asm volatile("s_waitcnt vmcnt(0)" ::: "memory");
        }
    }
    __syncthreads();
}
struct Frame {
    LAS unsigned char* lds; volatile LAS unsigned* MISC;
    int tid, lane, wave, vcu, G;
    unsigned char* ws; float* out; const float* const* inp;
};
#define FIN(k) (F.inp[k])
#define F_x FIN(0)
#define F_mem FIN(1)
#define F_ln_g FIN(2)
#define F_w_in FIN(3)
#define F_gm_g FIN(4)
#define F_gm_b FIN(5)
#define F_gm_ws FIN(6)
#define F_gm_bs FIN(7)
#define F_conv_w FIN(8)
#define F_a_log FIN(9)
#define F_dt_bias FIN(10)
#define F_dn_g FIN(11)
#define F_mem_g FIN(12)
#define F_w_mem FIN(13)
#define F_w_out FIN(14)
#define F_final_g FIN(15)
#define F_ctl ((gu32*)(F.ws + WS_CTL))
#define F_XB ((bf16*)(F.ws + WS_XB))
#define F_WTIN ((bf16*)(F.ws + WS_WTIN))
#define F_WTOUT ((bf16*)(F.ws + WS_WTOUT))
#define F_MKV ((bf16*)(F.ws + WS_MKV))
#define F_P ((bf16*)(F.ws + WS_P))
#define F_MIXED ((bf16*)(F.ws + WS_MIXED))
#define F_SG ((bf16*)(F.ws + WS_SG))
#define F_AP ((bf16*)(F.ws + WS_AP))
#define F_BNT ((bf16*)(F.ws + WS_BNT))
#define F_QEFF ((bf16*)((unsigned char*)F.out + OUT_QEFF))
#define F_OIN ((bf16*)((unsigned char*)F.out + OUT_OIN))
#define F_RSTD ((float*)(F.ws + WS_RSTD))
#define F_AB ((float*)(F.ws + WS_AB))
#define F_GLX ((float*)(F.ws + WS_GLX))
#define DI __device__ __forceinline__
typedef unsigned u32x2 __attribute__((ext_vector_type(2)));
typedef float f32x2 __attribute__((ext_vector_type(2)));
typedef __bf16 bf16x2_t __attribute__((ext_vector_type(2)));
DI unsigned cvtpk(float lo, float hi) { const f32x2 f = {lo, hi}; const bf16x2_t v = __builtin_convertvector(f, bf16x2_t); return __builtin_bit_cast(unsigned, v); }
DI float bflo(unsigned w) { return __builtin_bit_cast(float, w << 16); }
DI float bfhi(unsigned w) { return __builtin_bit_cast(float, w & 0xffff0000u); }
DI float bf1(bf16 h) { return __builtin_bit_cast(float, (unsigned)h << 16); }
DI float fexp(float x) { return __builtin_amdgcn_exp2f(x * 1.44269504089f); }
DI float frcp(float x) { return __builtin_amdgcn_rcpf(x); }
DI float sigm(float x) { return frcp(1.f + fexp(-x)); }
DI float silu_f(float x) { return x * sigm(x); }
DI float gelu_f(float x) { const float y = 1.5957691216057308f * (x + 0.044715f * x * x * x); return x * sigm(y); }
DI float softplus_f(float x) { return fmaxf(x, 0.f) + __logf(1.f + fexp(-fabsf(x))); }
DI float wave_sum(float v) {
#pragma unroll
    for (int o = 1; o < 64; o <<= 1) v += __shfl_xor(v, o);
    return v;
}
#define MFMA16(a, b, c) __builtin_amdgcn_mfma_f32_16x16x32_bf16((a), (b), (c), 0, 0, 0)
#define LDSW() asm volatile("s_waitcnt lgkmcnt(0)" ::: "memory")
DI void wg_sync() { __syncthreads(); }
DI f32x4 tile16(const LAS unsigned char* A, int lda, const LAS unsigned char* B, int ldb, int ksteps, f32x4 acc, int r, int q) {
    const LAS unsigned char* pa = A + r * lda + 16 * q; const LAS unsigned char* pb = B + r * ldb + 16 * q;
    for (int k = 0; k < ksteps; ++k) { const bf16x8 a = *(const LAS bf16x8*)(pa + 64 * k), b = *(const LAS bf16x8*)(pb + 64 * k); acc = MFMA16(a, b, acc); }
    return acc;
}

template <int MODE  >
DI void p0_transpose_item(const float* W, int srcN, int nblk, const float* g, bf16* WT, int row_off, LAS float* scr, int item, int lane) {
    const int kb = item / nblk, nb = item % nblk, k0 = 64 * kb, n0 = 64 * nb;
    const int nn = 4 * (lane & 15), np = n0 + nn;
    int sc = np; bool valid = true;
    if (MODE == 0) { sc = np < 5632 ? np : (np < 6656 ? np + 16 : 5632 + (np - 6656)); valid = np < NIN; }
    f32x4 v[16];
#pragma unroll
    for (int i = 0; i < 16; ++i) { const int kk = 4 * i + (lane >> 4); v[i] = (f32x4){0.f, 0.f, 0.f, 0.f}; if (valid) v[i] = *(const GAS f32x4*)(W + (size_t)(k0 + kk) * srcN + sc); }
#pragma unroll
    for (int i = 0; i < 16; ++i) { const int kk = 4 * i + (lane >> 4); f32x4 w = v[i]; if (MODE == 0) w = w * g[k0 + kk];
        LAS float* d = scr + kk * 65 + nn; d[0] = w.x; d[1] = w.y; d[2] = w.z; d[3] = w.w; }
    LDSW();
#pragma unroll
    for (int j = 0; j < 8; ++j) { const int p = lane + 64 * j, n = p >> 3, c = p & 7; const LAS float* s = scr + (8 * c) * 65 + n;
        v4u o; o.x = cvtpk(s[0 * 65], s[1 * 65]); o.y = cvtpk(s[2 * 65], s[3 * 65]); o.z = cvtpk(s[4 * 65], s[5 * 65]); o.w = cvtpk(s[6 * 65], s[7 * 65]);
        *(GAS v4u*)(WT + (size_t)(row_off + n0 + n) * DM + k0 + 8 * c) = o; }
    LDSW();
}
DI void p0_row(const float* xrow, bf16* orow, const float* g, float* rstd_out, int lane) {
    const GAS f32x4* xr = (const GAS f32x4*)xrow + lane;
    f32x4 v[8]; float s = 0.f;
#pragma unroll
    for (int j = 0; j < 8; ++j) { v[j] = xr[64 * j]; s += (v[j].x * v[j].x + v[j].y * v[j].y) + (v[j].z * v[j].z + v[j].w * v[j].w); }
    const float rs = 1.f / sqrtf(wave_sum(s) * (1.f / DM) + EPSF);
    if (rstd_out && lane == 0) *rstd_out = rs;
    GAS u32x2* o8 = (GAS u32x2*)orow + lane;
#pragma unroll
    for (int j = 0; j < 8; ++j) { f32x4 w = v[j]; if (g) { const f32x4 gg = ((const GAS f32x4*)g)[64 * j + lane]; w = w * rs * gg; }
        u32x2 o; o.x = cvtpk(w.x, w.y); o.y = cvtpk(w.z, w.w); o8[64 * j] = o; }
}
DI void p0_prologue(Frame& F) {
    LAS float* scr = (LAS float*)(F.lds + F.wave * 17408);
    const int gw = F.vcu * NWAVES + F.wave, NGW = F.G * NWAVES;
    constexpr int NB_IN = 105, I_IN = 32 * NB_IN, I_MEM = 32 * 16, I_OUT = 32 * 32, NITEMS = I_IN + I_MEM + I_OUT;
    for (int it = gw; it < NITEMS; it += NGW) {
        int r = it;
        if (r < I_IN) { p0_transpose_item<0>(F_w_in, NIN, NB_IN, F_ln_g, F_WTIN, 0, scr, r, F.lane); continue; } r -= I_IN;
        if (r < I_MEM) { p0_transpose_item<1>(F_w_mem, 1024, 16, nullptr, F_WTIN, NPADC, scr, r, F.lane); continue; } r -= I_MEM;
        p0_transpose_item<1>(F_w_out, 2048, 32, nullptr, F_WTOUT, 0, scr, r, F.lane);
    }
    { GAS v4u* z = (GAS v4u*)(F_WTIN + (size_t)6720 * DM); const int n16 = (NPADC - 6720) * DM * 2 / 16;
      for (int i = gw * 64 + F.lane; i < n16; i += NGW * 64) z[i] = (v4u){0u, 0u, 0u, 0u}; }
    for (int m = gw; m < SEQ + NMEMT; m += NGW) {
        if (m < SEQ) p0_row(F_x + (size_t)m * DM, F_XB + (size_t)m * DM, nullptr, F_RSTD + m, F.lane);
        else p0_row(F_mem + (size_t)(m - SEQ) * DM, F_XB + (size_t)m * DM, F_mem_g, nullptr, F.lane);
    }
}

DI void gmlp_item(Frame& F, int item) {
    int lane_ = F.lane, tid_ = F.tid; asm volatile("" : "+v"(lane_), "+v"(tid_));
    const int c = item >> 2, g = item & 3, t0 = 128 * c, lane = lane_, w = F.wave, r = lane & 15, q = lane >> 4;
    LAS unsigned char* Wb = F.lds; LAS unsigned char* VT = F.lds + 34816;
    { const float* Wg = F_gm_ws + (size_t)g * 16384;
#pragma unroll
      for (int i = 0; i < 8; ++i) { const int e = tid_ * 4 + i * 2048, row = e >> 7, col = e & 127; const f32x4 v = *(const GAS f32x4*)(Wg + e);
          u32x2 o; o.x = cvtpk(col <= row ? v.x : 0.f, col + 1 <= row ? v.y : 0.f); o.y = cvtpk(col + 2 <= row ? v.z : 0.f, col + 3 <= row ? v.w : 0.f);
          *(LAS u32x2*)(Wb + row * 272 + col * 2) = o; } }
#pragma unroll 1
    for (int i = 0; i < 16; ++i) { const int s = 16 * w + i;
        const v4u raw = *(const GAS v4u*)(F_P + (size_t)(t0 + s) * PLD + PC_GV + 8 * lane);
        float gv[8]; gv[0] = gelu_f(bflo(raw.x)); gv[1] = gelu_f(bfhi(raw.x)); gv[2] = gelu_f(bflo(raw.y)); gv[3] = gelu_f(bfhi(raw.y));
        gv[4] = gelu_f(bflo(raw.z)); gv[5] = gelu_f(bfhi(raw.z)); gv[6] = gelu_f(bflo(raw.w)); gv[7] = gelu_f(bfhi(raw.w));
        float sm = 0.f;
#pragma unroll
        for (int j = 0; j < 8; ++j) sm += gv[j];
        const float mean = wave_sum(sm) * (1.f / 512.f); float sq = 0.f;
#pragma unroll
        for (int j = 0; j < 8; ++j) { gv[j] -= mean; sq += gv[j] * gv[j]; }
        const float rs = 1.f / sqrtf(wave_sum(sq) * (1.f / 512.f) + EPSF);
        if ((lane >> 4) == g) {
#pragma unroll
            for (int j = 0; j < 8; ++j) { const int d = 8 * (lane & 15) + j; const float val = gv[j] * rs * F_gm_g[128 * g + d] + F_gm_b[128 * g + d];
                *(LAS unsigned short*)(VT + d * 272 + s * 2) = (unsigned short)cvtpk(val, 0.f); } }
    }
    LDSW(); wg_sync();
    f32x4 acc[8]; const int ks = (w >> 1) + 1;
#pragma unroll
    for (int dt = 0; dt < 8; ++dt) { acc[dt] = (f32x4){0.f, 0.f, 0.f, 0.f}; acc[dt] = tile16(VT + 16 * dt * 272, 272, Wb + 16 * w * 272, 272, ks, acc[dt], r, q); }
    { const int tl = 16 * w + r, t = t0 + tl; const float bsv = F_gm_bs[g * 128 + tl];
      const bf16* prow = F_P + (size_t)t * PLD + 128 * g + 4 * q; bf16* orow = F_MIXED + (size_t)t * DM + MC_A + 128 * g + 4 * q;
#pragma unroll
      for (int dt = 0; dt < 8; ++dt) { const u32x2 u = *(const GAS u32x2*)(prow + PC_GU + 16 * dt), z = *(const GAS u32x2*)(prow + PC_GZ + 16 * dt);
          const float o0 = gelu_f(bflo(u.x)) * (acc[dt][0] + bsv) * silu_f(bflo(z.x)), o1 = gelu_f(bfhi(u.x)) * (acc[dt][1] + bsv) * silu_f(bfhi(z.x));
          const float o2 = gelu_f(bflo(u.y)) * (acc[dt][2] + bsv) * silu_f(bflo(z.y)), o3 = gelu_f(bfhi(u.y)) * (acc[dt][3] + bsv) * silu_f(bfhi(z.y));
          u32x2 o; o.x = cvtpk(o0, o1); o.y = cvtpk(o2, o3); *(GAS u32x2*)(orow + 16 * dt) = o; } }
    wg_sync();
}

DI void xattn_item(Frame& F, int item) {
    int lane_ = F.lane, tid_ = F.tid; asm volatile("" : "+v"(lane_), "+v"(tid_));
    const int h = item & 3, qb = item >> 2, t0 = 128 * qb, lane = lane_, w = F.wave, r = lane & 15, q = lane >> 4;
    LAS unsigned char* KL = F.lds; LAS unsigned char* VL = F.lds + 69632;
    { const bf16* mk = F_MKV + 128 * h; const bf16* mv = F_MKV + 512 + 128 * h;
#pragma unroll
      for (int i = 0; i < 8; ++i) { const int c = tid_ + 512 * i, key = c >> 4, ch = c & 15;
          *(LAS v4u*)(KL + key * 272 + ch * 16) = *(const GAS v4u*)(mk + (size_t)key * 1024 + ch * 8);
          const v4u vv = *(const GAS v4u*)(mv + (size_t)key * 1024 + ch * 8); LAS unsigned char* vp = VL + (ch * 8) * 528 + key * 2;
          *(LAS unsigned short*)(vp) = (unsigned short)vv.x; *(LAS unsigned short*)(vp + 528) = (unsigned short)(vv.x >> 16);
          *(LAS unsigned short*)(vp + 2 * 528) = (unsigned short)vv.y; *(LAS unsigned short*)(vp + 3 * 528) = (unsigned short)(vv.y >> 16);
          *(LAS unsigned short*)(vp + 4 * 528) = (unsigned short)vv.z; *(LAS unsigned short*)(vp + 5 * 528) = (unsigned short)(vv.z >> 16);
          *(LAS unsigned short*)(vp + 6 * 528) = (unsigned short)vv.w; *(LAS unsigned short*)(vp + 7 * 528) = (unsigned short)(vv.w >> 16); } }
    const int t = t0 + 16 * w + r;
    bf16x8 bq[4];
#pragma unroll
    for (int ks = 0; ks < 4; ++ks) bq[ks] = *(const GAS bf16x8*)(F_P + (size_t)t * PLD + PC_CQ + 128 * h + 32 * ks + 8 * q);
    LDSW(); wg_sync();
    f32x4 s[16];
#pragma unroll
    for (int kt = 0; kt < 16; ++kt) { s[kt] = (f32x4){0.f, 0.f, 0.f, 0.f};
#pragma unroll
        for (int ks = 0; ks < 4; ++ks) { const bf16x8 a = *(const LAS bf16x8*)(KL + (16 * kt + r) * 272 + 64 * ks + 16 * q); s[kt] = MFMA16(a, bq[ks], s[kt]); }
        if (kt & 1) __builtin_amdgcn_sched_barrier(0); }
    float mx = -3.0e38f;
#pragma unroll
    for (int kt = 0; kt < 16; ++kt) mx = fmaxf(fmaxf(fmaxf(s[kt][0], s[kt][1]), fmaxf(s[kt][2], s[kt][3])), mx);
    mx = fmaxf(mx, __shfl_xor(mx, 16)); mx = fmaxf(mx, __shfl_xor(mx, 32));
    const float sc = 0.08838834764831845f * 1.44269504089f; float l = 0.f;
#pragma unroll
    for (int kt = 0; kt < 16; ++kt)
#pragma unroll
        for (int j = 0; j < 4; ++j) { const float p = __builtin_amdgcn_exp2f((s[kt][j] - mx) * sc); s[kt][j] = p; l += p; }
    l += __shfl_xor(l, 16); l += __shfl_xor(l, 32);
    f32x4 o[8];
#pragma unroll
    for (int dt = 0; dt < 8; ++dt) o[dt] = (f32x4){0.f, 0.f, 0.f, 0.f};
#pragma unroll
    for (int kk = 0; kk < 8; ++kk) {
        v4u pw; pw.x = cvtpk(s[2 * kk][0], s[2 * kk][1]); pw.y = cvtpk(s[2 * kk][2], s[2 * kk][3]); pw.z = cvtpk(s[2 * kk + 1][0], s[2 * kk + 1][1]); pw.w = cvtpk(s[2 * kk + 1][2], s[2 * kk + 1][3]);
        const bf16x8 bp = __builtin_bit_cast(bf16x8, pw);
#pragma unroll
        for (int dt = 0; dt < 8; ++dt) { const LAS unsigned char* vp = VL + (16 * dt + r) * 528 + 64 * kk + 8 * q;
            const u32x2 lo = *(const LAS u32x2*)vp, hi = *(const LAS u32x2*)(vp + 32);
            v4u av; av.x = lo.x; av.y = lo.y; av.z = hi.x; av.w = hi.y;
            o[dt] = MFMA16(__builtin_bit_cast(bf16x8, av), bp, o[dt]); }
        __builtin_amdgcn_sched_barrier(0); }
    { const float inv = 1.f / l; const bf16* zrow = F_P + (size_t)t * PLD + PC_CZ + 128 * h + 4 * q; bf16* orow = F_MIXED + (size_t)t * DM + MC_C + 128 * h + 4 * q;
#pragma unroll
      for (int dt = 0; dt < 8; ++dt) { const u32x2 z = *(const GAS u32x2*)(zrow + 16 * dt);
          u32x2 ov; ov.x = cvtpk(o[dt][0] * inv * silu_f(bflo(z.x)), o[dt][1] * inv * silu_f(bfhi(z.x))); ov.y = cvtpk(o[dt][2] * inv * silu_f(bflo(z.y)), o[dt][3] * inv * silu_f(bfhi(z.y)));
          *(GAS u32x2*)(orow + 16 * dt) = ov; } }
    wg_sync();
}
constexpr int L_KB = 0, L_QB = 17408, L_KT = 34816, L_VT = 52224, L_GT = 70656, L_DT = 89088, L_AF = 107520, L_TB = 124928, L_AI = 134144, L_SM = 143360, L_SS = 145408;
DI void dnprep_item(Frame& F, int item) {
    int lane_ = F.lane, tid_ = F.tid; asm volatile("" : "+v"(lane_), "+v"(tid_));
    const int h = item >> 7, n = item & 127, t0 = 64 * n, lane = lane_, w = F.wave, tid = tid_, r = lane & 15, q = lane >> 4;
    LAS unsigned char* L = F.lds;
    LAS float* gcs = (LAS float*)(L + L_SM); LAS float* bts = gcs + 64; LAS float* ssq = gcs + 128;
    LAS float* TF = (LAS float*)(L + L_KT); LAS float* AF = (LAS float*)(L + L_AF); LAS float* SS = (LAS float*)(L + L_SS);
    if (w == 0) {
#if defined(DBG_AB)
        float a = 0.f, b = 0.f;
        { const float* xr = F_x + (size_t)(t0 + lane) * DM; const float* wi = F_w_in; const float* lg = F_ln_g; float ssx = 0.f;
          for (int k = 0; k < DM; ++k) { const float xv_ = xr[k]; ssx += xv_ * xv_; const float hk = xv_ * lg[k]; a += hk * wi[(size_t)k * NIN + 5632 + h]; b += hk * wi[(size_t)k * NIN + 5640 + h]; }
          const float rs_ = 1.f / sqrtf(ssx * (1.f / DM) + EPSF); a *= rs_; b *= rs_; }
#else
        const float a = F_AB[(size_t)(t0 + lane) * 16 + h], b = F_AB[(size_t)(t0 + lane) * 16 + 8 + h];
#endif
        float g = -__expf(F_a_log[h]) * softplus_f(a + F_dt_bias[h]);
#pragma unroll
        for (int o = 1; o < 64; o <<= 1) { const float u = __shfl_up(g, o); if (lane >= o) g += u; }
        gcs[lane] = g; bts[lane] = sigm(b);
        if (lane == 63) F_GLX[item] = __expf(g);
    }
    for (int i = tid; i < 9216 / 4; i += 512) ((LAS unsigned*)(L + L_TB))[i] = 0u;
    const int d = tid & 127, oct = tid >> 7;
    LDSW(); wg_sync();
    const float gl = gcs[63];
#pragma unroll 1
    for (int p = 0; p < 2; ++p) { const int tb = 8 * (oct + 4 * p);
        float yq[8], yk[8];
#pragma unroll
        for (int sgi = 0; sgi < 3; ++sgi) { const int col = (sgi == 0 ? PC_DQ : (sgi == 1 ? PC_DK : PC_DV)) + 128 * h + d; const int cw = sgi * 1024 + 128 * h + d;
            const float w0 = F_conv_w[cw], w1 = F_conv_w[3072 + cw], w2 = F_conv_w[6144 + cw], w3 = F_conv_w[9216 + cw];
            float xv[11];
#pragma unroll
            for (int j = 0; j < 11; ++j) { const int tt = t0 + tb - 3 + j, tc = tt < 0 ? 0 : tt; const float xl = bf1(F_P[(size_t)tc * PLD + col]); xv[j] = tt < 0 ? 0.f : xl; }
            float y[8];
#pragma unroll
            for (int i = 0; i < 8; ++i) y[i] = silu_f(w0 * xv[i] + w1 * xv[i + 1] + w2 * xv[i + 2] + w3 * xv[i + 3]);
            if (sgi == 0) {
#pragma unroll
                for (int i = 0; i < 8; ++i) yq[i] = y[i];
            } else if (sgi == 1) {
#pragma unroll
                for (int i = 0; i < 8; ++i) yk[i] = y[i];
            } else {
#pragma unroll
                for (int i = 0; i < 8; ++i) y[i] *= bts[tb + i];
                v4u o; o.x = cvtpk(y[0], y[1]); o.y = cvtpk(y[2], y[3]); o.z = cvtpk(y[4], y[5]); o.w = cvtpk(y[6], y[7]); *(LAS v4u*)(L + L_VT + d * 144 + tb * 2) = o;
            }
            asm volatile("" ::: "memory");
        }
#pragma unroll
        for (int i = 0; i < 8; ++i) { const float sq_ = wave_sum(yq[i] * yq[i]), sk_ = wave_sum(yk[i] * yk[i]);
            if (lane == 0) { ssq[((w & 1) * 2 + 0) * 64 + tb + i] = sq_; ssq[((w & 1) * 2 + 1) * 64 + tb + i] = sk_; } }
        LDSW(); wg_sync();
        float kg[8], kd[8];
#pragma unroll
        for (int i = 0; i < 8; ++i) { const int t = tb + i;
            const float rnq = 0.08838834764831845f / sqrtf(ssq[t] + ssq[128 + t] + EPSF), rnk = 1.f / sqrtf(ssq[64 + t] + ssq[192 + t] + EPSF);
            const float bt = bts[t], gc = gcs[t], kk = yk[i] * rnk;
            *(LAS unsigned short*)(L + L_QB + t * 272 + d * 2) = (unsigned short)cvtpk(yq[i] * rnq, 0.f);
            *(LAS unsigned short*)(L + L_KB + t * 272 + d * 2) = (unsigned short)cvtpk(kk, 0.f);
            *(LAS unsigned short*)(L + L_KT + t * 272 + d * 2) = (unsigned short)cvtpk(kk * bt, 0.f);
            kg[i] = kk * bt * __expf(gc); kd[i] = kk * __expf(gl - gc); }
        v4u o; o.x = cvtpk(kg[0], kg[1]); o.y = cvtpk(kg[2], kg[3]); o.z = cvtpk(kg[4], kg[5]); o.w = cvtpk(kg[6], kg[7]); *(LAS v4u*)(L + L_GT + d * 144 + tb * 2) = o;
        o.x = cvtpk(kd[0], kd[1]); o.y = cvtpk(kd[2], kd[3]); o.z = cvtpk(kd[4], kd[5]); o.w = cvtpk(kd[6], kd[7]); *(LAS v4u*)(L + L_DT + d * 144 + tb * 2) = o;
    }
    LDSW(); wg_sync();
    { const int which = w >> 2, it = w & 3; const int i = 16 * it + r; const float gi = gcs[i];
      for (int jt = 0; jt < 4; ++jt) { f32x4 acc = (f32x4){0.f, 0.f, 0.f, 0.f};
          if (jt <= it) acc = tile16(L + L_KB + 16 * jt * 272, 272, L + (which ? L_QB : L_KT) + 16 * it * 272, 272, 4, acc, r, q);
          float v[4];
#pragma unroll
          for (int j = 0; j < 4; ++j) { const int jc = 16 * jt + 4 * q + j; const bool keep = which ? (i >= jc) : (i > jc); v[j] = keep ? acc[j] * __expf(gi - gcs[jc]) : 0.f; }
          if (which) { u32x2 o; o.x = cvtpk(v[0], v[1]); o.y = cvtpk(v[2], v[3]); *(LAS u32x2*)(L + L_AI + i * 144 + (16 * jt + 4 * q) * 2) = o; }
          else *(LAS f32x4*)(AF + i * 68 + 16 * jt + 4 * q) = (f32x4){v[0], v[1], v[2], v[3]}; } }
    LDSW(); wg_sync();
    if (w == 0) { const int b = lane >> 4, c = lane & 15; float tt[16];
#pragma unroll
        for (int i = 0; i < 16; ++i) { float v = (i == c) ? 1.f : 0.f;
#pragma unroll
            for (int j = 0; j < i; ++j) v -= AF[(16 * b + i) * 68 + 16 * b + j] * tt[j];
            tt[i] = v; TF[(16 * b + i) * 68 + 16 * b + c] = v; asm volatile("" ::: "memory"); } }
    LDSW(); wg_sync();
    for (int Lv = 1; Lv < 4; ++Lv) { const int np_ = 4 - Lv;
        for (int o = tid; o < np_ * 256; o += 512) { const int p = o >> 8, rr = (o >> 4) & 15, cc = o & 15, bj = p, bi = p + Lv; float s = 0.f;
            for (int m = 16 * bj; m < 16 * bi; ++m) s += AF[(16 * bi + rr) * 68 + m] * TF[m * 68 + 16 * bj + cc];
            SS[o] = s; }
        LDSW(); wg_sync();
        for (int o = tid; o < np_ * 256; o += 512) { const int p = o >> 8, rr = (o >> 4) & 15, cc = o & 15, bj = p, bi = p + Lv; float s = 0.f;
#pragma unroll
            for (int m = 0; m < 16; ++m) s += TF[(16 * bi + rr) * 68 + 16 * bi + m] * SS[p * 256 + m * 16 + cc];
            TF[(16 * bi + rr) * 68 + 16 * bj + cc] = -s; }
        LDSW(); wg_sync(); }
    for (int o = tid; o < 2048; o += 512) { const int i = o >> 5, j2 = (o & 31) * 2; if ((j2 >> 4) <= (i >> 4)) *(LAS unsigned*)(L + L_TB + i * 144 + j2 * 2) = cvtpk(TF[i * 68 + j2], TF[i * 68 + j2 + 1]); }
    LDSW(); wg_sync();
    { const int which = w >> 2, it = w & 3; f32x4 acc[8];
#pragma unroll
      for (int dt = 0; dt < 8; ++dt) { acc[dt] = (f32x4){0.f, 0.f, 0.f, 0.f}; acc[dt] = tile16(L + L_TB + 16 * it * 144, 144, L + (which ? L_GT : L_VT) + 16 * dt * 144, 144, 2, acc[dt], r, q); }
      LDSW(); wg_sync();
#pragma unroll
      for (int dt = 0; dt < 8; ++dt) { u32x2 o; o.x = cvtpk(acc[dt][0], acc[dt][1]); o.y = cvtpk(acc[dt][2], acc[dt][3]);
#if defined(DBG_O) && DBG_O == 1
          if (which)
#endif
          *(LAS u32x2*)(L + (which ? L_GT : L_VT) + (16 * dt + r) * 144 + (16 * it + 4 * q) * 2) = o; } }
    LDSW(); wg_sync();
    { bf16* Ap = F_AP + (size_t)item * 16384; bf16* BnT = F_BNT + (size_t)item * 16384; bf16* Qe = F_QEFF + (size_t)item * 8192; bf16* Oi = F_OIN + (size_t)item * 8192;
#pragma unroll
      for (int d2t = 0; d2t < 8; ++d2t) { f32x4 acc = (f32x4){0.f, 0.f, 0.f, 0.f}; acc = tile16(L + L_GT + 16 * d2t * 144, 144, L + L_DT + 16 * w * 144, 144, 2, acc, r, q);
          u32x2 o; o.x = cvtpk(-acc[0], -acc[1]); o.y = cvtpk(-acc[2], -acc[3]);
          *(GAS u32x2*)(Ap + (((w * 4 + (d2t >> 1)) * 64 + ((d2t & 1) * 2 + (q >> 1)) * 16 + r) * 8 + 4 * (q & 1))) = o; }
#pragma unroll
      for (int d1t = 0; d1t < 8; ++d1t) { f32x4 acc = (f32x4){0.f, 0.f, 0.f, 0.f}; acc = tile16(L + L_DT + 16 * d1t * 144, 144, L + L_VT + 16 * w * 144, 144, 2, acc, r, q);
          u32x2 o; o.x = cvtpk(acc[0], acc[1]); o.y = cvtpk(acc[2], acc[3]); *(GAS u32x2*)(BnT + (16 * w + r) * 128 + 16 * d1t + 4 * q) = o; }
      { const int it = w & 3, dh = w >> 2, i = 16 * it + r; const float eg = __expf(gcs[i]);
#pragma unroll
        for (int dd = 0; dd < 4; ++dd) { const int dt = 4 * dh + dd, dc = 16 * dt + 4 * q;
            f32x4 a1 = (f32x4){0.f, 0.f, 0.f, 0.f}, a2 = a1;
            a1 = tile16(L + L_GT + 16 * dt * 144, 144, L + L_AI + 16 * it * 144, 144, 2, a1, r, q);
            a2 = tile16(L + L_VT + 16 * dt * 144, 144, L + L_AI + 16 * it * 144, 144, 2, a2, r, q);
            const u32x2 qv = *(const LAS u32x2*)(L + L_QB + i * 272 + dc * 2);
            u32x2 o; o.x = cvtpk(bflo(qv.x) * eg - a1[0], bfhi(qv.x) * eg - a1[1]); o.y = cvtpk(bflo(qv.y) * eg - a1[2], bfhi(qv.y) * eg - a1[3]);
            *(GAS u32x2*)(Qe + i * 128 + dc) = o;
#if defined(DBG_O)
            { float vv[4];
#pragma unroll
              for (int j = 0; j < 4; ++j) vv[j] = bf1(*(const LAS unsigned short*)(L + L_VT + (dc + j) * 144 + i * 2));
              a2 = (f32x4){vv[0], vv[1], vv[2], vv[3]}; }
#endif
            o.x = cvtpk(a2[0], a2[1]); o.y = cvtpk(a2[2], a2[3]); *(GAS u32x2*)(Oi + i * 128 + dc) = o; } } }
    wg_sync();
}

struct ScanSet { bf16x8 af[4]; u32x2 bn[2]; float eg; };
DI void scan_load(Frame& F, ScanSet& s, int item, int w, int e0, int lane, int r, int q, int zlane) {
    const bf16* Ap = F_AP + (size_t)item * 16384 + (size_t)(w * 4) * 512 + lane * 8;
#pragma unroll
    for (int ks = 0; ks < 4; ++ks) s.af[ks] = *(const GAS bf16x8*)(Ap + ks * 512);
    const bf16* BnT = F_BNT + (size_t)item * 16384 + (size_t)(e0 + r) * 128 + 16 * w + 4 * q;
    s.bn[0] = *(const GAS u32x2*)BnT; s.bn[1] = *(const GAS u32x2*)(BnT + 16 * 128);
    s.eg = F_GLX[item + zlane];
}
DI void scan_step(Frame& F, const ScanSet& s, f32x4 (&acc)[2], int item, int buf, int w, int e0, int r, int q) {
    LAS unsigned char* ST = F.lds + buf * 8704;
    bf16* Sg = F_SG + (size_t)item * 16384 + (size_t)(e0 + r) * 128 + 16 * w + 4 * q;
#pragma unroll
    for (int et = 0; et < 2; ++et) { u32x2 o; o.x = cvtpk(acc[et][0], acc[et][1]); o.y = cvtpk(acc[et][2], acc[et][3]);
        *(LAS u32x2*)(ST + (16 * et + r) * 272 + (16 * w + 4 * q) * 2) = o; *(GAS u32x2*)(Sg + et * 16 * 128) = o; }
    LDSW(); __builtin_amdgcn_s_barrier(); asm volatile("" ::: "memory");
    bf16x8 bfr[2][4];
#pragma unroll
    for (int et = 0; et < 2; ++et)
#pragma unroll
        for (int ks = 0; ks < 4; ++ks) bfr[et][ks] = *(const LAS bf16x8*)(ST + (16 * et + r) * 272 + 64 * ks + 16 * q);
#pragma unroll
    for (int et = 0; et < 2; ++et) { f32x4 c;
        c[0] = acc[et][0] * s.eg + bflo(s.bn[et].x); c[1] = acc[et][1] * s.eg + bfhi(s.bn[et].x); c[2] = acc[et][2] * s.eg + bflo(s.bn[et].y); c[3] = acc[et][3] * s.eg + bfhi(s.bn[et].y);
#pragma unroll
        for (int ks = 0; ks < 4; ++ks) c = MFMA16(s.af[ks], bfr[et][ks], c);
        acc[et] = c; }
}
DI void scan_slice(Frame& F, int h, int slice) {
    const int lane = F.lane, w = F.wave, r = lane & 15, q = lane >> 4, e0 = 32 * slice, i0 = h * 128;
    f32x4 acc[2] = {(f32x4){0.f, 0.f, 0.f, 0.f}, (f32x4){0.f, 0.f, 0.f, 0.f}};
    ScanSet s0, s1, s2, s3;
    int zlane = 0; asm volatile("" : "+v"(zlane));
    scan_load(F, s0, i0, w, e0, lane, r, q, zlane); scan_load(F, s1, i0 + 1, w, e0, lane, r, q, zlane); scan_load(F, s2, i0 + 2, w, e0, lane, r, q, zlane);
    for (int n = 0; n < 128; n += 4) {
        scan_load(F, s3, i0 + n + 3, w, e0, lane, r, q, zlane);
        scan_step(F, s0, acc, i0 + n, 0, w, e0, r, q);
        if (n + 4 < 128) scan_load(F, s0, i0 + n + 4, w, e0, lane, r, q, zlane);
        scan_step(F, s1, acc, i0 + n + 1, 1, w, e0, r, q);
        if (n + 4 < 128) scan_load(F, s1, i0 + n + 5, w, e0, lane, r, q, zlane);
        scan_step(F, s2, acc, i0 + n + 2, 0, w, e0, r, q);
        if (n + 4 < 128) scan_load(F, s2, i0 + n + 6, w, e0, lane, r, q, zlane);
        scan_step(F, s3, acc, i0 + n + 3, 1, w, e0, r, q);
    }
    LDSW(); wg_sync();
}

DI void dnout_item(Frame& F, int item, int wi) {
    const int h = item >> 7, n = item & 127, lane = F.lane, r = lane & 15, q = lane >> 4;
    const int i = 16 * wi + r, t = 64 * n + i;
    const bf16* Qe = F_QEFF + (size_t)item * 8192 + i * 128 + 8 * q; const bf16* Sg = F_SG + (size_t)item * 16384 + r * 128 + 8 * q;
    bf16x8 bq[4];
#pragma unroll
    for (int ks = 0; ks < 4; ++ks) bq[ks] = *(const GAS bf16x8*)(Qe + 32 * ks);
    f32x4 o[8]; float ss = 0.f;
    const bf16* Oi = F_OIN + (size_t)item * 8192 + i * 128 + 4 * q;
#pragma unroll
    for (int dt = 0; dt < 8; ++dt) { const u32x2 oi = *(const GAS u32x2*)(Oi + 16 * dt); f32x4 c = (f32x4){bflo(oi.x), bfhi(oi.x), bflo(oi.y), bfhi(oi.y)};
#if !defined(DBG_NOSTATE)
#pragma unroll
        for (int ks = 0; ks < 4; ++ks) { const bf16x8 a = *(const GAS bf16x8*)(Sg + (size_t)(16 * dt) * 128 + 32 * ks); c = MFMA16(a, bq[ks], c); }
#endif
        o[dt] = c; ss += (c[0] * c[0] + c[1] * c[1]) + (c[2] * c[2] + c[3] * c[3]); }
    ss += __shfl_xor(ss, 16); ss += __shfl_xor(ss, 32);
    const float rs = 1.f / sqrtf(ss * (1.f / 128.f) + EPSF);
    const bf16* zrow = F_P + (size_t)t * PLD + PC_DZ + 128 * h + 4 * q; bf16* orow = F_MIXED + (size_t)t * DM + MC_B + 128 * h + 4 * q;
#pragma unroll
    for (int dt = 0; dt < 8; ++dt) { const u32x2 z = *(const GAS u32x2*)(zrow + 16 * dt); const f32x4 gg = *(const GAS f32x4*)(F_dn_g + 16 * dt + 4 * q);
        u32x2 ov; ov.x = cvtpk(o[dt][0] * rs * gg[0] * silu_f(bflo(z.x)), o[dt][1] * rs * gg[1] * silu_f(bfhi(z.x)));
        ov.y = cvtpk(o[dt][2] * rs * gg[2] * silu_f(bflo(z.y)), o[dt][3] * rs * gg[3] * silu_f(bfhi(z.y)));
        *(GAS u32x2*)(orow + 16 * dt) = ov; }
}
DI void final_row(float* row, const float* g, int lane) {
    GAS f32x4* xr = (GAS f32x4*)row + lane; f32x4 v[8]; float s = 0.f;
#pragma unroll
    for (int j = 0; j < 8; ++j) { v[j] = xr[64 * j]; s += (v[j].x * v[j].x + v[j].y * v[j].y) + (v[j].z * v[j].z + v[j].w * v[j].w); }
    const float rs = 1.f / sqrtf(wave_sum(s) * (1.f / DM) + EPSF);
#pragma unroll
    for (int j = 0; j < 8; ++j) { const f32x4 gg = ((const GAS f32x4*)g)[64 * j + lane]; xr[64 * j] = v[j] * rs * gg; }
}
struct Args { const float* in[16]; float* out; unsigned char* ws; int ph_lo, ph_hi, li, pad; };
__global__ void __launch_bounds__(NWAVES * 64, 2) fwd_kernel(Args args) {
    extern __shared__ __attribute__((aligned(16))) unsigned char lds[];
    Frame F;
    F.lds = (LAS unsigned char*)lds; F.MISC = (volatile LAS unsigned*)(F.lds + MISC_OFF);
    F.tid = threadIdx.x; F.lane = F.tid & 63; F.wave = __builtin_amdgcn_readfirstlane(F.tid >> 6);
    F.G = gridDim.x; { const int bx = blockIdx.x; F.vcu = (F.G % 8 == 0) ? (bx % 8) * (F.G / 8) + bx / 8 : bx; }
    F.ws = args.ws; F.out = args.out;
    F.inp = (const float* const*)__builtin_amdgcn_kernarg_segment_ptr();
    for (int u = F.tid; u < (LDS_BYTES - LDSCTL_OFF) / 4; u += NWAVES * 64) ((LAS unsigned*)(F.lds + LDSCTL_OFF))[u] = 0u;
    __syncthreads();
    XcdBarrier bar; bar.bar = (unsigned*)(F_ctl + CW_BAR); bar.x = 0; bar.st = nullptr;
    if (N_LAUNCHES == 1) bar = xcd_barrier_post((unsigned*)(F_ctl + CW_BAR), F.MISC + 8);
#define GRID_BAR() do { if (N_LAUNCHES == 1) xcd_barrier(bar); } while (0)
    const int lo = args.ph_lo, hi = args.ph_hi;
#if defined(DBG_TS_I)
    volatile unsigned long long* tsw = (volatile unsigned long long*)(F.ws + 512 * 1024);
    const bool stamper = (blockIdx.x == 0 && threadIdx.x == 0);
    if (stamper) tsw[15] = __builtin_amdgcn_s_memrealtime();
#define STAMP(k) do { if (stamper) tsw[k] = __builtin_amdgcn_s_memrealtime(); } while (0)
#else
#define STAMP(k) do {} while (0)
#endif
#ifndef ITEM_MASK
#define ITEM_MASK 7
#endif
#ifndef PH_MASK
#define PH_MASK 0x7f
#endif
#define IN(k) (((PH_MASK >> (k)) & 1) && lo <= (k) && (k) < hi)
#define BOTH(k) (IN(k) && IN((k) + 1))
#ifndef REP_MASK
#define REP_MASK 0
#endif
#define REPS(k) for (int rep_ = 0; rep_ <= ((REP_MASK >> (k)) & 1); ++rep_)
#define REFRESH() do { int t_ = threadIdx.x; asm volatile("" : "+v"(t_)); F.tid = t_; F.lane = t_ & 63; } while (0)
    if (IN(0)) REPS(0) { REFRESH(); p0_prologue(F); if (BOTH(0)) GRID_BAR(); STAMP(0); }
    if (IN(1)) REPS(1) {
        pg8::Gemm g{F_XB, F_WTIN, SEQ + NMEMT, NPADC + 1024, DM}; pg8::Order1 S; S.init(F.G, (int)blockIdx.x);
        pg8::EpiProj E{F_P, F_AB, F_RSTD, F_MKV};
        pg8::gemm_phase<pg8::EpiProj, pg8::Order1, true, true>(F.lds, g, S, E);
        if (BOTH(1)) GRID_BAR(); STAMP(1);
    }
    if (IN(2)) REPS(2) {
        REFRESH();
        if (ITEM_MASK & 1) for (int it = F.vcu; it < 1024; it += F.G) dnprep_item(F, it);
        if (ITEM_MASK & 2) for (int it = F.vcu; it < 256; it += F.G) gmlp_item(F, it);
        if (ITEM_MASK & 4) for (int it = F.vcu; it < 256; it += F.G) xattn_item(F, it);
        if (BOTH(2)) GRID_BAR(); STAMP(2);
    }
    if (IN(3)) REPS(3) { REFRESH(); if (blockIdx.x < 32) scan_slice(F, (int)blockIdx.x & 7, (int)blockIdx.x >> 3); if (BOTH(3)) GRID_BAR(); STAMP(3); }
    if (IN(4)) REPS(4) { REFRESH(); for (int it = (int)blockIdx.x * 2 + (F.wave >> 2); it < 1024; it += 2 * F.G) dnout_item(F, it, F.wave & 3); if (BOTH(4)) GRID_BAR(); STAMP(4); }
    if (IN(5)) REPS(5) {
        pg8::Gemm g{F_MIXED, F_WTOUT, SEQ, DM, DM}; pg8::StaticOrder S; S.init(SEQ, DM, F.G, (int)blockIdx.x);
        pg8::EpiRes E{F_x, F.out};
        pg8::gemm_phase<pg8::EpiRes, pg8::StaticOrder, true, true>(F.lds, g, S, E);
        if (BOTH(5)) GRID_BAR(); STAMP(5);
    }
    if (IN(6)) { REFRESH(); const int gw = F.vcu * NWAVES + F.wave, NGW = F.G * NWAVES; for (int m = gw; m < SEQ; m += NGW) final_row(F.out + (size_t)m * DM, F_final_g, F.lane);
#if defined(DBG_TS_I)
        if (stamper) { const float vi = (float)(tsw[DBG_TS_I] - tsw[15]) * 0.01f, vj = (float)(tsw[DBG_TS_J] - tsw[15]) * 0.01f; F.out[0] += vj; for (int j = 1; j < 8; ++j) { F.out[256 * j] += vi; F.out[256 * j + 1] += vi; F.out[256 * j + 2] += vi; F.out[256 * j + 3] += vi; } }
#endif
    }
#undef IN
#undef BOTH
}

extern "C" void kernel_launch(void* const* d_in, const int* in_sizes, int n_in, void* d_out, int out_size, void* d_ws, size_t ws_size, hipStream_t stream) {
    static int grid = 0;
    if (grid == 0) {
        if (n_in != 16 || in_sizes[0] != SEQ * DM || out_size != SEQ * DM || ws_size < WS_END) { fprintf(stderr, "kernel_launch: unexpected shapes (n_in %d, in0 %d, out %d, ws %zu); nothing launched\n", n_in, n_in > 0 ? in_sizes[0] : -1, out_size, ws_size); grid = -1; return; }
        int dev = 0, cus = 0, per_cu = 0;
        if (hipGetDevice(&dev) != hipSuccess || hipDeviceGetAttribute(&cus, hipDeviceAttributeMultiprocessorCount, dev) != hipSuccess) { grid = -1; return; }
        if (hipFuncSetAttribute((const void*)fwd_kernel, hipFuncAttributeMaxDynamicSharedMemorySize, LDS_BYTES) != hipSuccess) { fprintf(stderr, "kernel_launch: hipFuncSetAttribute failed\n"); grid = -1; return; }
        if (hipOccupancyMaxActiveBlocksPerMultiprocessor(&per_cu, (const void*)fwd_kernel, NWAVES * 64, LDS_BYTES) != hipSuccess || per_cu < 1) fprintf(stderr, "kernel_launch: note: occupancy query reports %d\n", per_cu);
        (void)hipGetLastError();
        grid = cus;
    }
    if (grid < 0) return;
    if (hipMemsetAsync((char*)d_ws + WS_CTL, 0, CTL_ZERO_BYTES, stream) != hipSuccess) return;
    Args a{};
    for (int i = 0; i < 16; ++i) a.in[i] = (const float*)d_in[i];
    a.out = (float*)d_out; a.ws = (unsigned char*)d_ws;
    for (int li = 0; li < N_LAUNCHES; ++li) {
        a.ph_lo = (N_LAUNCHES == 1) ? 0 : li; a.ph_hi = (N_LAUNCHES == 1) ? N_PHASES : li + 1; a.li = li;
        hipLaunchKernelGGL(fwd_kernel, dim3(grid), dim3(NWAVES * 64), LDS_BYTES, stream, a);
        if (hipPeekAtLastError() != hipSuccess) { fprintf(stderr, "kernel_launch: launch %d failed\n", li); break; }
    }
}
```

```cpp
#include <hip/hip_runtime.h>
#include <cstdio>
#include <cstdint>
#ifndef MK_N_LAUNCHES
#define MK_N_LAUNCHES 1
#endif
namespace pg8 {
#define PG8_LAS __attribute__((address_space(3)))
typedef unsigned short bf16_t;
typedef short bf16x8 __attribute__((ext_vector_type(8)));
typedef float f32x4 __attribute__((ext_vector_type(4)));
typedef unsigned u32x4 __attribute__((ext_vector_type(4)));
constexpr int BM = 256, BK = 64, HALF = 128, HTB = HALF * BK * 2  , STAGE_BYTES = 8 * HTB, NXCD = 8, WGM = 8;

__host__ __device__ __forceinline__ int lds_byte(int r, int c) { const int st = (r >> 4) * 2 + (c >> 5), rr = r & 15, cc = c & 31, ob = rr * 64 + cc * 2; return st * 1024 + (ob ^ (((ob >> 9) & 1) << 5)); }
__host__ __device__ __forceinline__ void stage_rc(int b, int& R, int& C) { const int st = b / 1024, sb = b % 1024, swz = sb ^ (((sb >> 9) & 1) << 5); R = (st >> 1) * 16 + swz / 64; C = (st & 1) * 32 + (swz % 64) / 2; }
__host__ __device__ __forceinline__ int perm32(int rho) { const int n = rho >> 4, i = rho & 15; return 8 * (i >> 2) + 4 * n + (i & 3); }

struct Unit { int pm, pn; };
struct Gemm { const bf16_t* A; const bf16_t* Bt; int M, N, K; };

struct StaticOrder {
    int nM, nN, nwg, G, c;
    __host__ __device__ void init(int M, int N, int G_, int c_) { nM = M / BM; nN = N / BM; nwg = nM * nN; G = G_; c = c_; }
    __host__ __device__ bool next(int i, Unit& u) const {
        const long L = (long)i * G + c; if (L >= nwg) return false;
        int wgid = (int)L; { const int q = nwg / NXCD, r = nwg % NXCD, xcd = wgid % NXCD, off = wgid / NXCD; wgid = (xcd < r ? xcd * (q + 1) : r * (q + 1) + (xcd - r) * q) + off; }
        const int nig = WGM * nN, gid = wgid / nig, fm = gid * WGM, gsz = (nM - fm) < WGM ? (nM - fm) : WGM;
        u.pm = fm + ((wgid % nig) % gsz); u.pn = (wgid % nig) / gsz; return true;
    }
    __device__ __forceinline__ void a_ready(const Unit&) const {}
    __device__ __forceinline__ void done(const Unit&) const {}
};

__device__ __forceinline__ unsigned cvt_pk_bf16(float lo, float hi) { unsigned r; asm volatile("v_cvt_pk_bf16_f32 %0, %1, %2" : "=v"(r) : "v"(lo), "v"(hi)); return r; }
struct EpiProj {
    static constexpr bool PERM = true, AFTER_DRAIN = false;
    bf16_t* P; float* AB; const float* rstd; bf16_t* MKV;
    __device__ __forceinline__ void operator()(const f32x4 (&acc)[2][2][4][2], const Unit& u, int wr, int wc, int fr, int fq) const {
        const int row0 = wr * 64 + fr; const bool memt = u.pm >= 32;
        const float* rsp = rstd + (memt ? 0 : u.pm * BM);
        if (u.pn != 26) {
            bf16_t* base = memt ? MKV + (size_t)(u.pn - 27) * BM : P + (size_t)u.pm * BM * 6656 + (size_t)u.pn * BM; const int ldc = memt ? 1024 : 6656;
            base += wc * 32 + 8 * fq;
#pragma unroll
            for (int ai = 0; ai < 2; ++ai)
#pragma unroll
                for (int m = 0; m < 4; ++m) { const int row = row0 + ai * HALF + m * 16; const float rs = memt ? 1.f : rsp[row]; bf16_t* rowp = base + (size_t)row * ldc;
#pragma unroll
                    for (int bj = 0; bj < 2; ++bj) { const f32x4 v0 = acc[ai][bj][m][0] * rs, v1 = acc[ai][bj][m][1] * rs;
                        u32x4 w; w.x = cvt_pk_bf16(v0[0], v0[1]); w.y = cvt_pk_bf16(v0[2], v0[3]); w.z = cvt_pk_bf16(v1[0], v1[1]); w.w = cvt_pk_bf16(v1[2], v1[3]);
                        *(u32x4*)(rowp + bj * HALF) = w; } }
        } else if (wc == 0 && fq < 2) {
#pragma unroll
            for (int ai = 0; ai < 2; ++ai)
#pragma unroll
                for (int m = 0; m < 4; ++m) { const int row = row0 + ai * HALF + m * 16; const float rs = rsp[row];
#pragma unroll
                    for (int n = 0; n < 2; ++n) *(f32x4*)(AB + (size_t)(u.pm * BM + row) * 16 + 8 * fq + 4 * n) = acc[ai][0][m][n] * rs; }
        }
    }
};
struct EpiRes {
    static constexpr bool PERM = false, AFTER_DRAIN = false;
    const float* X; float* O;
    __device__ __forceinline__ void operator()(const f32x4 (&acc)[2][2][4][2], const Unit& u, int wr, int wc, int fr, int fq) const {
        const int row0 = u.pm * BM + wr * 64 + fr, col0 = u.pn * BM + wc * 32 + 4 * fq;
#pragma unroll
        for (int ai = 0; ai < 2; ++ai)
#pragma unroll
            for (int m = 0; m < 4; ++m) { const size_t off = (size_t)(row0 + ai * HALF + m * 16) * 2048 + col0;
#pragma unroll
                for (int bj = 0; bj < 2; ++bj)
#pragma unroll
                    for (int n = 0; n < 2; ++n) { const f32x4 xv = *(const f32x4*)(X + off + bj * HALF + n * 16); *(f32x4*)(O + off + bj * HALF + n * 16) = xv + acc[ai][bj][m][n]; } }
    }
};
struct Order1 {
    StaticOrder so; int G, c;
    __device__ void init(int G_, int c_) { so.init(8192, 6912, G_, c_); G = G_; c = c_; }
    __device__ bool next(int i, Unit& u) const { const long L = (long)i * G + c; if (L < 864) return so.next(i, u); if (L < 868) { u.pm = 32; u.pn = 27 + (int)(L - 864); return true; } return false; }
    __device__ __forceinline__ void a_ready(const Unit&) const {}
    __device__ __forceinline__ void done(const Unit&) const {}
};
template <class Epi, class Sched, bool ALIGN_EPI = false, bool SP2 = false>
__device__ __forceinline__ void gemm_phase(PG8_LAS unsigned char* lds, const Gemm g, const Sched& S, const Epi& E) {
    const int tid = threadIdx.x, wid = __builtin_amdgcn_readfirstlane(tid >> 6), lane = tid & 63, wr = wid >> 2, wc = wid & 3, fr = lane & 15, fq = lane >> 4;
    const int K = g.K, nt = K / BK;
    unsigned voffA[2], voffB[2];
#pragma unroll
    for (int i = 0; i < 2; ++i) { int R, C; stage_rc(tid * 16 + i * 8192, R, C); const int Rb = Epi::PERM ? ((R & ~31) + perm32(R & 31)) : R;
        voffA[i] = (unsigned)(R * K + C) * 2u; voffB[i] = (unsigned)(Rb * K + C) * 2u; }
    const size_t kstep = (size_t)(BK * 2);
    const size_t hstep = (size_t)HALF * K * 2;
    const size_t tstep = 2 * hstep;
    const unsigned ldsw = (unsigned)wid * 1024u;
    const int aoff = lds_byte(wr * 64 + fr, fq * 8), boff = lds_byte(wc * 32 + fr, fq * 8);
#define PG8_SA(b, h) (((b) * 2 + (h)) * HTB)
#define PG8_SB(b, h) ((4 + (b) * 2 + (h)) * HTB)
#define PG8_STAGE(bufoff, gbase, voff) do { _Pragma("unroll") for (int _i = 0; _i < 2; ++_i) \
        __builtin_amdgcn_global_load_lds((const unsigned*)((const char*)(gbase) + (voff)[_i]), (PG8_LAS unsigned*)(lds + (bufoff) + ldsw + _i * 8192), 16, 0, 0); } while (0)
#define PG8_LDA(dst, b, h) do { _Pragma("unroll") for (int m = 0; m < 4; ++m) _Pragma("unroll") for (int k = 0; k < 2; ++k) dst[m][k] = *(const PG8_LAS bf16x8*)(lds + PG8_SA(b, h) + aoff + m * 2048 + k * 1024); } while (0)
#define PG8_LDB(dst, b, h) do { _Pragma("unroll") for (int n = 0; n < 2; ++n) _Pragma("unroll") for (int k = 0; k < 2; ++k) dst[n][k] = *(const PG8_LAS bf16x8*)(lds + PG8_SB(b, h) + boff + n * 2048 + k * 1024); } while (0)
#define PG8_MMA(ai, bj, At, Bt) do { __builtin_amdgcn_s_setprio(1); _Pragma("unroll") for (int m = 0; m < 4; ++m) _Pragma("unroll") for (int n = 0; n < 2; ++n) _Pragma("unroll") for (int k = 0; k < 2; ++k) \
        acc[ai][bj][m][n] = __builtin_amdgcn_mfma_f32_16x16x32_bf16(Bt[n][k], At[m][k], acc[ai][bj][m][n], 0, 0, 0); __builtin_amdgcn_s_setprio(0); } while (0)
#define PG8_WAIT_V(n) asm volatile("s_waitcnt vmcnt(" #n ")" ::: "memory")
#define PG8_WAIT_L(n) asm volatile("s_waitcnt lgkmcnt(" #n ")" ::: "memory")
#define PG8_BAR __builtin_amdgcn_s_barrier()
#define PG8_SCHED __builtin_amdgcn_sched_barrier(0)
    Unit cur, nxt; int ui = 0;
    if (!S.next(0, cur)) return;
    f32x4 acc[2][2][4][2];
#pragma unroll
    for (int a = 0; a < 2; ++a)
#pragma unroll
        for (int b = 0; b < 2; ++b)
#pragma unroll
            for (int m = 0; m < 4; ++m)
#pragma unroll
                for (int n = 0; n < 2; ++n) acc[a][b][m][n] = (f32x4){0.f, 0.f, 0.f, 0.f};
    bf16x8 At[4][2], B0[2][2], B1[2][2];
    const char* cA = (const char*)g.A + (size_t)cur.pm * tstep; const char* cB = (const char*)g.Bt + (size_t)cur.pn * tstep;
    S.a_ready(cur);
    if constexpr (SP2) {
        PG8_STAGE(PG8_SB(0, 0), cB, voffB); PG8_STAGE(PG8_SB(0, 1), cB + hstep, voffB); PG8_STAGE(PG8_SA(0, 0), cA, voffA); PG8_STAGE(PG8_SA(0, 1), cA + hstep, voffA);
        if (wr == 1) PG8_BAR;
        PG8_WAIT_V(2); PG8_BAR;
        PG8_STAGE(PG8_SB(1, 0), cB + kstep, voffB); PG8_STAGE(PG8_SA(1, 0), cA + kstep, voffA); PG8_STAGE(PG8_SB(1, 1), cB + hstep + kstep, voffB);
        PG8_WAIT_V(6); PG8_BAR;
    } else {
        PG8_STAGE(PG8_SB(0, 0), cB, voffB); PG8_STAGE(PG8_SA(0, 0), cA, voffA); PG8_STAGE(PG8_SB(0, 1), cB + hstep, voffB); PG8_STAGE(PG8_SA(0, 1), cA + hstep, voffA);
        if (wr == 1) PG8_BAR;
        PG8_WAIT_V(4); PG8_BAR;
        PG8_STAGE(PG8_SB(1, 0), cB + kstep, voffB); PG8_STAGE(PG8_SA(1, 0), cA + kstep, voffA); PG8_STAGE(PG8_SB(1, 1), cB + hstep + kstep, voffB);
        PG8_WAIT_V(6); PG8_BAR;
    }
    for (;;) {
        const bool has_next = S.next(ui + 1, nxt);
        const char* nA = has_next ? (const char*)g.A + (size_t)nxt.pm * tstep : cA; const char* nB = has_next ? (const char*)g.Bt + (size_t)nxt.pn * tstep : cB;
        for (int t = 0; t < nt; t += 2) {
            const bool last = (t == nt - 2);
            const char* a1 = cA + (size_t)(t + 1) * kstep;
            const char* a2 = last ? nA : cA + (size_t)(t + 2) * kstep; const char* b2 = last ? nB : cB + (size_t)(t + 2) * kstep;
            const char* a3 = a2 + kstep; const char* b3 = b2 + kstep;
            if (last && has_next) S.a_ready(nxt);
            if constexpr (SP2) {
            PG8_LDB(B0, 0, 0); PG8_LDB(B1, 0, 1); PG8_SCHED; PG8_LDA(At, 0, 0); PG8_STAGE(PG8_SA(1, 1), a1 + hstep, voffA);
            PG8_WAIT_V(8); PG8_WAIT_L(0); PG8_BAR; PG8_MMA(0, 0, At, B0); PG8_MMA(0, 1, At, B1); PG8_BAR; PG8_SCHED;
            PG8_LDA(At, 0, 1); PG8_STAGE(PG8_SB(0, 0), b2, voffB); PG8_STAGE(PG8_SB(0, 1), b2 + hstep, voffB); PG8_STAGE(PG8_SA(0, 0), a2, voffA);
            PG8_WAIT_V(8); PG8_WAIT_L(0); PG8_BAR; PG8_MMA(1, 0, At, B0); PG8_MMA(1, 1, At, B1); PG8_BAR; PG8_SCHED;
            PG8_LDB(B0, 1, 0); PG8_LDB(B1, 1, 1); PG8_SCHED; PG8_LDA(At, 1, 0); PG8_STAGE(PG8_SA(0, 1), a2 + hstep, voffA);
            PG8_WAIT_V(8); PG8_WAIT_L(0); PG8_BAR; PG8_MMA(0, 0, At, B0); PG8_MMA(0, 1, At, B1); PG8_BAR; PG8_SCHED;
            PG8_LDA(At, 1, 1); PG8_STAGE(PG8_SB(1, 0), b3, voffB); PG8_STAGE(PG8_SB(1, 1), b3 + hstep, voffB); PG8_STAGE(PG8_SA(1, 0), a3, voffA);
            PG8_WAIT_V(8); PG8_WAIT_L(0); PG8_BAR; PG8_MMA(1, 0, At, B0); PG8_MMA(1, 1, At, B1); PG8_BAR; PG8_SCHED;
            } else {
            PG8_LDB(B0, 0, 0); PG8_SCHED; PG8_LDA(At, 0, 0); PG8_STAGE(PG8_SA(1, 1), a1 + hstep, voffA);
            PG8_WAIT_L(8); PG8_BAR; PG8_WAIT_L(0); PG8_MMA(0, 0, At, B0); PG8_BAR; PG8_SCHED;
            PG8_LDB(B1, 0, 1); PG8_STAGE(PG8_SB(0, 0), b2, voffB);
            PG8_BAR; PG8_WAIT_L(0); PG8_MMA(0, 1, At, B1); PG8_BAR;
            PG8_LDA(At, 0, 1); PG8_STAGE(PG8_SA(0, 0), a2, voffA);
            PG8_BAR; PG8_WAIT_L(0); PG8_MMA(1, 0, At, B0); PG8_BAR; PG8_SCHED;
            PG8_STAGE(PG8_SB(0, 1), b2 + hstep, voffB);
            PG8_WAIT_V(6); PG8_BAR; PG8_MMA(1, 1, At, B1); PG8_BAR;
            PG8_LDB(B0, 1, 0); PG8_SCHED; PG8_LDA(At, 1, 0); PG8_STAGE(PG8_SA(0, 1), a2 + hstep, voffA);
            PG8_WAIT_L(8); PG8_BAR; PG8_WAIT_L(0); PG8_MMA(0, 0, At, B0); PG8_BAR; PG8_SCHED;
            PG8_LDB(B1, 1, 1); PG8_STAGE(PG8_SB(1, 0), b3, voffB);
            PG8_BAR; PG8_WAIT_L(0); PG8_MMA(0, 1, At, B1); PG8_BAR;
            PG8_LDA(At, 1, 1); PG8_STAGE(PG8_SA(1, 0), a3, voffA);
            PG8_BAR; PG8_WAIT_L(0); PG8_MMA(1, 0, At, B0); PG8_BAR; PG8_SCHED;
            PG8_STAGE(PG8_SB(1, 1), b3 + hstep, voffB);
            PG8_WAIT_V(6); PG8_BAR; PG8_MMA(1, 1, At, B1); PG8_BAR;
            }
        }
        if constexpr (ALIGN_EPI) { if (wr == 0) PG8_BAR; }
        if constexpr (!Epi::AFTER_DRAIN) { E(acc, cur, wr, wc, fr, fq); S.done(cur); }
        if (!has_next) break;
#pragma unroll
        for (int a = 0; a < 2; ++a)
#pragma unroll
            for (int b = 0; b < 2; ++b)
#pragma unroll
                for (int m = 0; m < 4; ++m)
#pragma unroll
                    for (int n = 0; n < 2; ++n) acc[a][b][m][n] = (f32x4){0.f, 0.f, 0.f, 0.f};
        cur = nxt; cA = nA; cB = nB; ++ui;
        if constexpr (ALIGN_EPI) { if (wr == 1) PG8_BAR; }
    }
    PG8_WAIT_V(0);
    if constexpr (!ALIGN_EPI) { if (wr == 0) PG8_BAR; }
    PG8_BAR;
    if constexpr (Epi::AFTER_DRAIN) { E.fused(acc, cur, wr, wc, fr, fq, lds, wid, lane); S.done(cur); }
#undef PG8_SA
#undef PG8_SB
#undef PG8_STAGE
#undef PG8_LDA
#undef PG8_LDB
#undef PG8_MMA
#undef PG8_WAIT_V
#undef PG8_WAIT_L
#undef PG8_BAR
#undef PG8_SCHED
}
}
constexpr int NWAVES = 8;
constexpr int N_LAUNCHES = MK_N_LAUNCHES;
constexpr int N_PHASES = 7;
constexpr int SEQ = 8192, DM = 2048, NIN = 6672, NPADC = 6912, PLD = 6656, NMEMT = 256;
constexpr int PC_GU = 0, PC_GV = 512, PC_GZ = 1024, PC_DQ = 1536, PC_DK = 2560, PC_DV = 3584, PC_DZ = 4608, PC_CQ = 5632, PC_CZ = 6144;
constexpr int MC_A = 0, MC_B = 512, MC_C = 1536;
constexpr float EPSF = 1e-6f;
constexpr size_t MiB = 1u << 20;
constexpr size_t WS_CTL = 0, CTL_ZERO_BYTES = 1 * MiB;
constexpr size_t WS_XB = 2 * MiB;
constexpr size_t WS_WTIN = 36 * MiB;
constexpr size_t WS_WTOUT = 68 * MiB;
constexpr size_t WS_RSTD = 76 * MiB;
constexpr size_t WS_AB = 76 * MiB + 65536;
constexpr size_t WS_GLX = 76 * MiB + 655360;
constexpr size_t WS_GLXG = 76 * MiB + 659456;
constexpr size_t WS_MKV = 77 * MiB;
constexpr size_t WS_P = 78 * MiB;
constexpr size_t WS_MIXED = 182 * MiB;
constexpr size_t WS_APG = 214 * MiB;
constexpr size_t WS_BCT = 222 * MiB;
constexpr size_t WS_SGRP = 230 * MiB;
constexpr size_t WS_END = 246 * MiB;
constexpr size_t WS_AP = 2 * MiB;
constexpr size_t WS_BNT = 34 * MiB;
constexpr size_t OUT_QEFF = 0;
constexpr size_t OUT_OIN = 16 * MiB;
constexpr int CW_TMO = 0, CW_BAR = 4096;
constexpr int LDS_BYTES = 163840;
constexpr int LDSCTL_OFF = 162816, MISC_OFF = LDSCTL_OFF + 320;
#define GAS __attribute__((address_space(1)))
#define LAS __attribute__((address_space(3)))
typedef unsigned short bf16;
typedef unsigned v4u __attribute__((ext_vector_type(4)));
typedef float f32x4 __attribute__((ext_vector_type(4)));
typedef short bf16x8 __attribute__((ext_vector_type(8)));
typedef GAS unsigned gu32;
typedef GAS unsigned long long gu64;
#define RLX_AGENT __ATOMIC_RELAXED, __HIP_MEMORY_SCOPE_AGENT
#define LDS_WAIT() asm volatile("s_waitcnt lgkmcnt(0)" ::: "memory")
#define VM_WAIT() asm volatile("s_waitcnt vmcnt(0)" ::: "memory")
__device__ __forceinline__ unsigned long long rt() { return __builtin_amdgcn_s_memrealtime(); }
__device__ __forceinline__ unsigned f2bf(float f) { unsigned u = __builtin_bit_cast(unsigned, f); return (u + 0x7fffu + ((u >> 16) & 1u)) >> 16; }
__device__ __forceinline__ unsigned pk2(float lo, float hi) { return f2bf(lo) | (f2bf(hi) << 16); }

#define XB_TMO      128
#define XB_XCNT(j)  (256  + 64 * (j))
#define XB_XSUB(j)  (1280 + 64 * (j))
#define XB_XGEN(j)  (2304 + 64 * (j))
#define XB_TOP      3328
#define XB_TOPGEN   3392
#define XCD_BAR_WORDS 3456
#define XB_SPIN_CAP (1u << 18)

__device__ __forceinline__ unsigned xb_ld(unsigned* p)              { return __hip_atomic_load(p, __ATOMIC_RELAXED, __HIP_MEMORY_SCOPE_AGENT); }
__device__ __forceinline__ unsigned xb_add(unsigned* p, unsigned v) { return __hip_atomic_fetch_add(p, v, __ATOMIC_RELAXED, __HIP_MEMORY_SCOPE_AGENT); }
__device__ __forceinline__ unsigned xb_xcc_id() { return (unsigned)__builtin_amdgcn_s_getreg((3 << 11) | 20) & 0xFu; }
#define XB_SPIN(cond, bar) do { unsigned _sp = 0; while (cond) { __builtin_amdgcn_s_sleep(1); \
    if ((++_sp & 255u) == 0u) { if (xb_ld(&(bar)[XB_TMO])) break; if (_sp > XB_SPIN_CAP) { atomicAdd(&(bar)[XB_TMO], 1u); break; } } } } while (0)

struct XcdBarrier {
    unsigned* bar; unsigned x;
    volatile LAS unsigned* st;
};

__device__ __forceinline__ XcdBarrier xcd_barrier_post(unsigned* bar, volatile LAS unsigned* st) {
    XcdBarrier b; b.bar = bar; b.x = xb_xcc_id(); b.st = st;
    if (threadIdx.x == 0) (void)xb_add(&bar[XB_XCNT(b.x)], 1u);
    return b;
}
__device__ __forceinline__ void xcd_barrier_complete(unsigned* bar, unsigned x, unsigned& nloc, unsigned& nx) {
    const unsigned G = gridDim.x * gridDim.y * gridDim.z;
    unsigned sum, cnt, mine, sp = 0u;
    for (;;) {
        sum = 0u; cnt = 0u; mine = 0u;
#pragma unroll
        for (unsigned j = 0; j < 16; ++j) { const unsigned c = xb_ld(&bar[XB_XCNT(j)]); sum += c; cnt += (c > 0u) ? 1u : 0u; mine = (j == x) ? c : mine; }
        if (sum == G) break;
        __builtin_amdgcn_s_sleep(1);
        if ((++sp & 255u) == 0u) { if (xb_ld(&bar[XB_TMO])) break; if (sp > XB_SPIN_CAP) { atomicAdd(&bar[XB_TMO], 1u); break; } }
    }
    nloc = mine > 0u ? mine : 1u; nx = cnt > 0u ? cnt : 1u;
}

__device__ __forceinline__ void xcd_barrier(const XcdBarrier& b) {
    asm volatile("s_waitcnt vmcnt(0)" ::: "memory");
    __syncthreads();
    if (threadIdx.x == 0) {
        unsigned* bar = b.bar;
        __builtin_amdgcn_s_waitcnt(0);
        unsigned nloc = b.st[0], nx = b.st[1];
        if (nloc == 0u) { xcd_barrier_complete(bar, b.x, nloc, nx); b.st[0] = nloc; b.st[1] = nx; }
        const unsigned old = xb_add(&bar[XB_XSUB(b.x)], 1u);
        const unsigned gen = old / nloc;
        if (old + 1u == (gen + 1u) * nloc) {
            __builtin_amdgcn_fence(__ATOMIC_RELEASE, "agent");
            asm volatile("s_waitcnt vmcnt(0)" ::: "memory");
            const unsigned og = xb_add(&bar[XB_TOP], 1u);
            const unsigned tg = og / nx;
            if (og + 1u == (tg + 1u) * nx) xb_add(&bar[XB_TOPGEN], 1u);
            else XB_SPIN(xb_ld(&bar[XB_TOPGEN]) == tg, bar);
            __builtin_amdgcn_fence(__ATOMIC_ACQUIRE, "agent");
            xb_add(&bar[XB_XGEN(b.x)], 1u);
            asm volatile("s_waitcnt vmcnt(0)" ::: "memory");
        } else {
            XB_SPIN(xb_ld(&bar[XB_XGEN(b.x)]) == gen, bar);
            __builtin_amdgcn_fence(__ATOMIC_ACQUIRE, "agent");
            asm volatile("s_waitcnt vmcnt(0)" ::: "memory");
        }
    }
    __syncthreads();
}
struct Frame {
    LAS unsigned char* lds; volatile LAS unsigned* MISC;
    int tid, lane, wave, vcu, G;
    unsigned char* ws; float* out; const float* const* inp;
};
#define FIN(k) (F.inp[k])
#define F_x FIN(0)
#define F_mem FIN(1)
#define F_ln_g FIN(2)
#define F_w_in FIN(3)
#define F_gm_g FIN(4)
#define F_gm_b FIN(5)
#define F_gm_ws FIN(6)
#define F_gm_bs FIN(7)
#define F_conv_w FIN(8)
#define F_a_log FIN(9)
#define F_dt_bias FIN(10)
#define F_dn_g FIN(11)
#define F_mem_g FIN(12)
#define F_w_mem FIN(13)
#define F_w_out FIN(14)
#define F_final_g FIN(15)
#define F_ctl ((gu32*)(F.ws + WS_CTL))
#define F_XB ((bf16*)(F.ws + WS_XB))
#define F_WTIN ((bf16*)(F.ws + WS_WTIN))
#define F_WTOUT ((bf16*)(F.ws + WS_WTOUT))
#define F_MKV ((bf16*)(F.ws + WS_MKV))
#define F_P ((bf16*)(F.ws + WS_P))
#define F_MIXED ((bf16*)(F.ws + WS_MIXED))
#define F_APG ((bf16*)(F.ws + WS_APG))
#define F_BCT ((bf16*)(F.ws + WS_BCT))
#define F_SGRP ((bf16*)(F.ws + WS_SGRP))
#define F_GLXG ((float*)(F.ws + WS_GLXG))
#define F_AP ((bf16*)(F.ws + WS_AP))
#define F_BNT ((bf16*)(F.ws + WS_BNT))
#define F_QEFF ((bf16*)((unsigned char*)F.out + OUT_QEFF))
#define F_OIN ((bf16*)((unsigned char*)F.out + OUT_OIN))
#define F_RSTD ((float*)(F.ws + WS_RSTD))
#define F_AB ((float*)(F.ws + WS_AB))
#define F_GLX ((float*)(F.ws + WS_GLX))
#define DI __device__ __forceinline__
typedef unsigned u32x2 __attribute__((ext_vector_type(2)));
typedef float f32x2 __attribute__((ext_vector_type(2)));
typedef __bf16 bf16x2_t __attribute__((ext_vector_type(2)));
DI unsigned cvtpk(float lo, float hi) { const f32x2 f = {lo, hi}; const bf16x2_t v = __builtin_convertvector(f, bf16x2_t); return __builtin_bit_cast(unsigned, v); }
DI float bflo(unsigned w) { return __builtin_bit_cast(float, w << 16); }
DI float bfhi(unsigned w) { return __builtin_bit_cast(float, w & 0xffff0000u); }
DI float bf1(bf16 h) { return __builtin_bit_cast(float, (unsigned)h << 16); }
DI float fexp(float x) { return __builtin_amdgcn_exp2f(x * 1.44269504089f); }
DI float frcp(float x) { return __builtin_amdgcn_rcpf(x); }
DI float sigm(float x) { return frcp(1.f + fexp(-x)); }
DI float silu_f(float x) { return x * sigm(x); }
DI float gelu_f(float x) { const float y = 1.5957691216057308f * (x + 0.044715f * x * x * x); return x * sigm(y); }
DI float softplus_f(float x) { return fmaxf(x, 0.f) + __logf(1.f + fexp(-fabsf(x))); }
DI float wave_sum(float v) {
#pragma unroll
    for (int o = 1; o < 64; o <<= 1) v += __shfl_xor(v, o);
    return v;
}
#define MFMA16(a, b, c) __builtin_amdgcn_mfma_f32_16x16x32_bf16((a), (b), (c), 0, 0, 0)
#define LDSW() asm volatile("s_waitcnt lgkmcnt(0)" ::: "memory")
DI void wg_sync() { __syncthreads(); }
DI f32x4 tile16(const LAS unsigned char* A, int lda, const LAS unsigned char* B, int ldb, int ksteps, f32x4 acc, int r, int q) {
    const LAS unsigned char* pa = A + r * lda + 16 * q; const LAS unsigned char* pb = B + r * ldb + 16 * q;
    for (int k = 0; k < ksteps; ++k) { const bf16x8 a = *(const LAS bf16x8*)(pa + 64 * k), b = *(const LAS bf16x8*)(pb + 64 * k); acc = MFMA16(a, b, acc); }
    return acc;
}

template <int MODE  >
DI void p0_transpose_item(const float* W, int srcN, int nblk, const float* g, bf16* WT, int row_off, LAS float* scr, int item, int lane) {
    const int kb = item / nblk, nb = item % nblk, k0 = 64 * kb, n0 = 64 * nb;
    const int nn = 4 * (lane & 15), np = n0 + nn;
    int sc = np; bool valid = true;
    if (MODE == 0) { sc = np < 5632 ? np : (np < 6656 ? np + 16 : 5632 + (np - 6656)); valid = np < NIN; }
    f32x4 v[16];
#pragma unroll
    for (int i = 0; i < 16; ++i) { const int kk = 4 * i + (lane >> 4); v[i] = (f32x4){0.f, 0.f, 0.f, 0.f}; if (valid) v[i] = *(const GAS f32x4*)(W + (size_t)(k0 + kk) * srcN + sc); }
#pragma unroll
    for (int i = 0; i < 16; ++i) { const int kk = 4 * i + (lane >> 4); f32x4 w = v[i]; if (MODE == 0) w = w * g[k0 + kk];
        LAS float* d = scr + kk * 65 + nn; d[0] = w.x; d[1] = w.y; d[2] = w.z; d[3] = w.w; }
    LDSW();
#pragma unroll
    for (int j = 0; j < 8; ++j) { const int p = lane + 64 * j, n = p >> 3, c = p & 7; const LAS float* s = scr + (8 * c) * 65 + n;
        v4u o; o.x = cvtpk(s[0 * 65], s[1 * 65]); o.y = cvtpk(s[2 * 65], s[3 * 65]); o.z = cvtpk(s[4 * 65], s[5 * 65]); o.w = cvtpk(s[6 * 65], s[7 * 65]);
        *(GAS v4u*)(WT + (size_t)(row_off + n0 + n) * DM + k0 + 8 * c) = o; }
    LDSW();
}
DI void p0_row(const float* xrow, bf16* orow, const float* g, float* rstd_out, int lane) {
    const GAS f32x4* xr = (const GAS f32x4*)xrow + lane;
    f32x4 v[8]; float s = 0.f;
#pragma unroll
    for (int j = 0; j < 8; ++j) { v[j] = xr[64 * j]; s += (v[j].x * v[j].x + v[j].y * v[j].y) + (v[j].z * v[j].z + v[j].w * v[j].w); }
    const float rs = 1.f / sqrtf(wave_sum(s) * (1.f / DM) + EPSF);
    if (rstd_out && lane == 0) *rstd_out = rs;
    GAS u32x2* o8 = (GAS u32x2*)orow + lane;
#pragma unroll
    for (int j = 0; j < 8; ++j) { f32x4 w = v[j]; if (g) { const f32x4 gg = ((const GAS f32x4*)g)[64 * j + lane]; w = w * rs * gg; }
        u32x2 o; o.x = cvtpk(w.x, w.y); o.y = cvtpk(w.z, w.w); o8[64 * j] = o; }
}
DI void p0_prologue(Frame& F) {
    LAS float* scr = (LAS float*)(F.lds + F.wave * 17408);
    const int gw = F.vcu * NWAVES + F.wave, NGW = F.G * NWAVES;
    constexpr int NB_IN = 105, I_IN = 32 * NB_IN, I_MEM = 32 * 16, I_OUT = 32 * 32, NITEMS = I_IN + I_MEM + I_OUT;
    for (int it = gw; it < NITEMS; it += NGW) {
        int r = it;
        if (r < I_IN) { p0_transpose_item<0>(F_w_in, NIN, NB_IN, F_ln_g, F_WTIN, 0, scr, r, F.lane); continue; } r -= I_IN;
        if (r < I_MEM) { p0_transpose_item<1>(F_w_mem, 1024, 16, nullptr, F_WTIN, NPADC, scr, r, F.lane); continue; } r -= I_MEM;
        p0_transpose_item<1>(F_w_out, 2048, 32, nullptr, F_WTOUT, 0, scr, r, F.lane);
    }
    { GAS v4u* z = (GAS v4u*)(F_WTIN + (size_t)6720 * DM); const int n16 = (NPADC - 6720) * DM * 2 / 16;
      for (int i = gw * 64 + F.lane; i < n16; i += NGW * 64) z[i] = (v4u){0u, 0u, 0u, 0u}; }
    for (int m = gw; m < SEQ + NMEMT; m += NGW) {
        if (m < SEQ) p0_row(F_x + (size_t)m * DM, F_XB + (size_t)m * DM, nullptr, F_RSTD + m, F.lane);
        else p0_row(F_mem + (size_t)(m - SEQ) * DM, F_XB + (size_t)m * DM, F_mem_g, nullptr, F.lane);
    }
}

DI void gmlp_item(Frame& F, int item) {
    int lane_ = F.lane, tid_ = F.tid; asm volatile("" : "+v"(lane_), "+v"(tid_));
    const int c = item >> 2, g = item & 3, t0 = 128 * c, lane = lane_, w = F.wave, r = lane & 15, q = lane >> 4;
    LAS unsigned char* Wb = F.lds; LAS unsigned char* VT = F.lds + 34816;
    { const float* Wg = F_gm_ws + (size_t)g * 16384;
#pragma unroll
      for (int i = 0; i < 8; ++i) { const int e = tid_ * 4 + i * 2048, row = e >> 7, col = e & 127; const f32x4 v = *(const GAS f32x4*)(Wg + e);
          u32x2 o; o.x = cvtpk(col <= row ? v.x : 0.f, col + 1 <= row ? v.y : 0.f); o.y = cvtpk(col + 2 <= row ? v.z : 0.f, col + 3 <= row ? v.w : 0.f);
          *(LAS u32x2*)(Wb + row * 272 + col * 2) = o; } }
#pragma unroll 1
    for (int i = 0; i < 16; ++i) { const int s = 16 * w + i;
        const v4u raw = *(const GAS v4u*)(F_P + (size_t)(t0 + s) * PLD + PC_GV + 8 * lane);
        float gv[8]; gv[0] = gelu_f(bflo(raw.x)); gv[1] = gelu_f(bfhi(raw.x)); gv[2] = gelu_f(bflo(raw.y)); gv[3] = gelu_f(bfhi(raw.y));
        gv[4] = gelu_f(bflo(raw.z)); gv[5] = gelu_f(bfhi(raw.z)); gv[6] = gelu_f(bflo(raw.w)); gv[7] = gelu_f(bfhi(raw.w));
        float sm = 0.f;
#pragma unroll
        for (int j = 0; j < 8; ++j) sm += gv[j];
        const float mean = wave_sum(sm) * (1.f / 512.f); float sq = 0.f;
#pragma unroll
        for (int j = 0; j < 8; ++j) { gv[j] -= mean; sq += gv[j] * gv[j]; }
        const float rs = 1.f / sqrtf(wave_sum(sq) * (1.f / 512.f) + EPSF);
        if ((lane >> 4) == g) {
#pragma unroll
            for (int j = 0; j < 8; ++j) { const int d = 8 * (lane & 15) + j; const float val = gv[j] * rs * F_gm_g[128 * g + d] + F_gm_b[128 * g + d];
                *(LAS unsigned short*)(VT + d * 272 + s * 2) = (unsigned short)cvtpk(val, 0.f); } }
    }
    LDSW(); wg_sync();
    f32x4 acc[8]; const int ks = (w >> 1) + 1;
#pragma unroll
    for (int dt = 0; dt < 8; ++dt) { acc[dt] = (f32x4){0.f, 0.f, 0.f, 0.f}; acc[dt] = tile16(VT + 16 * dt * 272, 272, Wb + 16 * w * 272, 272, ks, acc[dt], r, q); }
    { const int tl = 16 * w + r, t = t0 + tl; const float bsv = F_gm_bs[g * 128 + tl];
      const bf16* prow = F_P + (size_t)t * PLD + 128 * g + 4 * q; bf16* orow = F_MIXED + (size_t)t * DM + MC_A + 128 * g + 4 * q;
#pragma unroll
      for (int dt = 0; dt < 8; ++dt) { const u32x2 u = *(const GAS u32x2*)(prow + PC_GU + 16 * dt), z = *(const GAS u32x2*)(prow + PC_GZ + 16 * dt);
          const float o0 = gelu_f(bflo(u.x)) * (acc[dt][0] + bsv) * silu_f(bflo(z.x)), o1 = gelu_f(bfhi(u.x)) * (acc[dt][1] + bsv) * silu_f(bfhi(z.x));
          const float o2 = gelu_f(bflo(u.y)) * (acc[dt][2] + bsv) * silu_f(bflo(z.y)), o3 = gelu_f(bfhi(u.y)) * (acc[dt][3] + bsv) * silu_f(bfhi(z.y));
          u32x2 o; o.x = cvtpk(o0, o1); o.y = cvtpk(o2, o3); *(GAS u32x2*)(orow + 16 * dt) = o; } }
    wg_sync();
}

DI void xattn_item(Frame& F, int item) {
    int lane_ = F.lane, tid_ = F.tid; asm volatile("" : "+v"(lane_), "+v"(tid_));
    const int h = item & 3, qb = item >> 2, t0 = 128 * qb, lane = lane_, w = F.wave, r = lane & 15, q = lane >> 4;
    LAS unsigned char* KL = F.lds; LAS unsigned char* VL = F.lds + 69632;
    { const bf16* mk = F_MKV + 128 * h; const bf16* mv = F_MKV + 512 + 128 * h;
#pragma unroll
      for (int i = 0; i < 8; ++i) { const int c = tid_ + 512 * i, key = c >> 4, ch = c & 15;
          *(LAS v4u*)(KL + key * 272 + ch * 16) = *(const GAS v4u*)(mk + (size_t)key * 1024 + ch * 8);
          const v4u vv = *(const GAS v4u*)(mv + (size_t)key * 1024 + ch * 8); LAS unsigned char* vp = VL + (ch * 8) * 528 + key * 2;
          *(LAS unsigned short*)(vp) = (unsigned short)vv.x; *(LAS unsigned short*)(vp + 528) = (unsigned short)(vv.x >> 16);
          *(LAS unsigned short*)(vp + 2 * 528) = (unsigned short)vv.y; *(LAS unsigned short*)(vp + 3 * 528) = (unsigned short)(vv.y >> 16);
          *(LAS unsigned short*)(vp + 4 * 528) = (unsigned short)vv.z; *(LAS unsigned short*)(vp + 5 * 528) = (unsigned short)(vv.z >> 16);
          *(LAS unsigned short*)(vp + 6 * 528) = (unsigned short)vv.w; *(LAS unsigned short*)(vp + 7 * 528) = (unsigned short)(vv.w >> 16); } }
    const int t = t0 + 16 * w + r;
    bf16x8 bq[4];
#pragma unroll
    for (int ks = 0; ks < 4; ++ks) bq[ks] = *(const GAS bf16x8*)(F_P + (size_t)t * PLD + PC_CQ + 128 * h + 32 * ks + 8 * q);
    LDSW(); wg_sync();
    f32x4 s[16];
#pragma unroll
    for (int kt = 0; kt < 16; ++kt) { s[kt] = (f32x4){0.f, 0.f, 0.f, 0.f};
#pragma unroll
        for (int ks = 0; ks < 4; ++ks) { const bf16x8 a = *(const LAS bf16x8*)(KL + (16 * kt + r) * 272 + 64 * ks + 16 * q); s[kt] = MFMA16(a, bq[ks], s[kt]); }
        if (kt & 1) __builtin_amdgcn_sched_barrier(0); }
    float mx = -3.0e38f;
#pragma unroll
    for (int kt = 0; kt < 16; ++kt) mx = fmaxf(fmaxf(fmaxf(s[kt][0], s[kt][1]), fmaxf(s[kt][2], s[kt][3])), mx);
    mx = fmaxf(mx, __shfl_xor(mx, 16)); mx = fmaxf(mx, __shfl_xor(mx, 32));
    const float sc = 0.08838834764831845f * 1.44269504089f; float l = 0.f;
#pragma unroll
    for (int kt = 0; kt < 16; ++kt)
#pragma unroll
        for (int j = 0; j < 4; ++j) { const float p = __builtin_amdgcn_exp2f((s[kt][j] - mx) * sc); s[kt][j] = p; l += p; }
    l += __shfl_xor(l, 16); l += __shfl_xor(l, 32);
    f32x4 o[8];
#pragma unroll
    for (int dt = 0; dt < 8; ++dt) o[dt] = (f32x4){0.f, 0.f, 0.f, 0.f};
#pragma unroll
    for (int kk = 0; kk < 8; ++kk) {
        v4u pw; pw.x = cvtpk(s[2 * kk][0], s[2 * kk][1]); pw.y = cvtpk(s[2 * kk][2], s[2 * kk][3]); pw.z = cvtpk(s[2 * kk + 1][0], s[2 * kk + 1][1]); pw.w = cvtpk(s[2 * kk + 1][2], s[2 * kk + 1][3]);
        const bf16x8 bp = __builtin_bit_cast(bf16x8, pw);
#pragma unroll
        for (int dt = 0; dt < 8; ++dt) { const LAS unsigned char* vp = VL + (16 * dt + r) * 528 + 64 * kk + 8 * q;
            const u32x2 lo = *(const LAS u32x2*)vp, hi = *(const LAS u32x2*)(vp + 32);
            v4u av; av.x = lo.x; av.y = lo.y; av.z = hi.x; av.w = hi.y;
            o[dt] = MFMA16(__builtin_bit_cast(bf16x8, av), bp, o[dt]); }
        __builtin_amdgcn_sched_barrier(0); }
    { const float inv = 1.f / l; const bf16* zrow = F_P + (size_t)t * PLD + PC_CZ + 128 * h + 4 * q; bf16* orow = F_MIXED + (size_t)t * DM + MC_C + 128 * h + 4 * q;
#pragma unroll
      for (int dt = 0; dt < 8; ++dt) { const u32x2 z = *(const GAS u32x2*)(zrow + 16 * dt);
          u32x2 ov; ov.x = cvtpk(o[dt][0] * inv * silu_f(bflo(z.x)), o[dt][1] * inv * silu_f(bfhi(z.x))); ov.y = cvtpk(o[dt][2] * inv * silu_f(bflo(z.y)), o[dt][3] * inv * silu_f(bfhi(z.y)));
          *(GAS u32x2*)(orow + 16 * dt) = ov; } }
    wg_sync();
}
constexpr int L_KB = 0, L_QB = 17408, L_KT = 34816, L_VT = 52224, L_GT = 70656, L_DT = 89088, L_AF = 107520, L_TB = 124928, L_AI = 134144, L_SM = 143360, L_SS = 145408;
DI void dnprep_item(Frame& F, int item, f32x4 (&X)[16], float& sigma, int j) {
    int lane_ = F.lane, tid_ = F.tid; asm volatile("" : "+v"(lane_), "+v"(tid_));
    const int h = item >> 7, n = item & 127, t0 = 64 * n, lane = lane_, w = F.wave, tid = tid_, r = lane & 15, q = lane >> 4;
    LAS unsigned char* L = F.lds;
    LAS float* gcs = (LAS float*)(L + L_SM); LAS float* bts = gcs + 64; LAS float* ssq = gcs + 128;
    LAS float* TF = (LAS float*)(L + L_KT); LAS float* AF = (LAS float*)(L + L_AF); LAS float* SS = (LAS float*)(L + L_SS);
    if (w == 0) {
#if defined(DBG_AB)
        float a = 0.f, b = 0.f;
        { const float* xr = F_x + (size_t)(t0 + lane) * DM; const float* wi = F_w_in; const float* lg = F_ln_g; float ssx = 0.f;
          for (int k = 0; k < DM; ++k) { const float xv_ = xr[k]; ssx += xv_ * xv_; const float hk = xv_ * lg[k]; a += hk * wi[(size_t)k * NIN + 5632 + h]; b += hk * wi[(size_t)k * NIN + 5640 + h]; }
          const float rs_ = 1.f / sqrtf(ssx * (1.f / DM) + EPSF); a *= rs_; b *= rs_; }
#else
        const float a = F_AB[(size_t)(t0 + lane) * 16 + h], b = F_AB[(size_t)(t0 + lane) * 16 + 8 + h];
#endif
        float g = -__expf(F_a_log[h]) * softplus_f(a + F_dt_bias[h]);
#pragma unroll
        for (int o = 1; o < 64; o <<= 1) { const float u = __shfl_up(g, o); if (lane >= o) g += u; }
        gcs[lane] = g; bts[lane] = sigm(b);
        if (lane == 63) F_GLX[item] = __expf(g);
    }
    for (int i = tid; i < 9216 / 4; i += 512) ((LAS unsigned*)(L + L_TB))[i] = 0u;
    const int d = tid & 127, oct = tid >> 7;
    LDSW(); wg_sync();
    const float gl = gcs[63];
#pragma unroll 1
    for (int p = 0; p < 2; ++p) { const int tb = 8 * (oct + 4 * p);
        float yq[8], yk[8];
#pragma unroll
        for (int sgi = 0; sgi < 3; ++sgi) { const int col = (sgi == 0 ? PC_DQ : (sgi == 1 ? PC_DK : PC_DV)) + 128 * h + d; const int cw = sgi * 1024 + 128 * h + d;
            const float w0 = F_conv_w[cw], w1 = F_conv_w[3072 + cw], w2 = F_conv_w[6144 + cw], w3 = F_conv_w[9216 + cw];
            float xv[11];
#pragma unroll
            for (int j = 0; j < 11; ++j) { const int tt = t0 + tb - 3 + j, tc = tt < 0 ? 0 : tt; const float xl = bf1(F_P[(size_t)tc * PLD + col]); xv[j] = tt < 0 ? 0.f : xl; }
            float y[8];
#pragma unroll
            for (int i = 0; i < 8; ++i) y[i] = silu_f(w0 * xv[i] + w1 * xv[i + 1] + w2 * xv[i + 2] + w3 * xv[i + 3]);
            if (sgi == 0) {
#pragma unroll
                for (int i = 0; i < 8; ++i) yq[i] = y[i];
            } else if (sgi == 1) {
#pragma unroll
                for (int i = 0; i < 8; ++i) yk[i] = y[i];
            } else {
#pragma unroll
                for (int i = 0; i < 8; ++i) y[i] *= bts[tb + i];
                v4u o; o.x = cvtpk(y[0], y[1]); o.y = cvtpk(y[2], y[3]); o.z = cvtpk(y[4], y[5]); o.w = cvtpk(y[6], y[7]); *(LAS v4u*)(L + L_VT + d * 144 + tb * 2) = o;
            }
            asm volatile("" ::: "memory");
        }
#pragma unroll
        for (int i = 0; i < 8; ++i) { const float sq_ = wave_sum(yq[i] * yq[i]), sk_ = wave_sum(yk[i] * yk[i]);
            if (lane == 0) { ssq[((w & 1) * 2 + 0) * 64 + tb + i] = sq_; ssq[((w & 1) * 2 + 1) * 64 + tb + i] = sk_; } }
        LDSW(); wg_sync();
        float kg[8], kd[8];
#pragma unroll
        for (int i = 0; i < 8; ++i) { const int t = tb + i;
            const float rnq = 0.08838834764831845f / sqrtf(ssq[t] + ssq[128 + t] + EPSF), rnk = 1.f / sqrtf(ssq[64 + t] + ssq[192 + t] + EPSF);
            const float bt = bts[t], gc = gcs[t], kk = yk[i] * rnk;
            *(LAS unsigned short*)(L + L_QB + t * 272 + d * 2) = (unsigned short)cvtpk(yq[i] * rnq, 0.f);
            *(LAS unsigned short*)(L + L_KB + t * 272 + d * 2) = (unsigned short)cvtpk(kk, 0.f);
            *(LAS unsigned short*)(L + L_KT + t * 272 + d * 2) = (unsigned short)cvtpk(kk * bt, 0.f);
            kg[i] = kk * bt * __expf(gc); kd[i] = kk * __expf(gl - gc); }
        v4u o; o.x = cvtpk(kg[0], kg[1]); o.y = cvtpk(kg[2], kg[3]); o.z = cvtpk(kg[4], kg[5]); o.w = cvtpk(kg[6], kg[7]); *(LAS v4u*)(L + L_GT + d * 144 + tb * 2) = o;
        o.x = cvtpk(kd[0], kd[1]); o.y = cvtpk(kd[2], kd[3]); o.z = cvtpk(kd[4], kd[5]); o.w = cvtpk(kd[6], kd[7]); *(LAS v4u*)(L + L_DT + d * 144 + tb * 2) = o;
    }
    LDSW(); wg_sync();
    { const int which = w >> 2, it = w & 3; const int i = 16 * it + r; const float gi = gcs[i];
      for (int jt = 0; jt < 4; ++jt) { f32x4 acc = (f32x4){0.f, 0.f, 0.f, 0.f};
          if (jt <= it) acc = tile16(L + L_KB + 16 * jt * 272, 272, L + (which ? L_QB : L_KT) + 16 * it * 272, 272, 4, acc, r, q);
          float v[4];
#pragma unroll
          for (int j = 0; j < 4; ++j) { const int jc = 16 * jt + 4 * q + j; const bool keep = which ? (i >= jc) : (i > jc); v[j] = keep ? acc[j] * __expf(gi - gcs[jc]) : 0.f; }
          if (which) { u32x2 o; o.x = cvtpk(v[0], v[1]); o.y = cvtpk(v[2], v[3]); *(LAS u32x2*)(L + L_AI + i * 144 + (16 * jt + 4 * q) * 2) = o; }
          else *(LAS f32x4*)(AF + i * 68 + 16 * jt + 4 * q) = (f32x4){v[0], v[1], v[2], v[3]}; } }
    LDSW(); wg_sync();
    if (w == 0) { const int b = lane >> 4, c = lane & 15; float tt[16];
#pragma unroll
        for (int i = 0; i < 16; ++i) { float v = (i == c) ? 1.f : 0.f;
#pragma unroll
            for (int j = 0; j < i; ++j) v -= AF[(16 * b + i) * 68 + 16 * b + j] * tt[j];
            tt[i] = v; TF[(16 * b + i) * 68 + 16 * b + c] = v; asm volatile("" ::: "memory"); } }
    LDSW(); wg_sync();
    for (int Lv = 1; Lv < 4; ++Lv) { const int np_ = 4 - Lv;
        for (int o = tid; o < np_ * 256; o += 512) { const int p = o >> 8, rr = (o >> 4) & 15, cc = o & 15, bj = p, bi = p + Lv; float s = 0.f;
            for (int m = 16 * bj; m < 16 * bi; ++m) s += AF[(16 * bi + rr) * 68 + m] * TF[m * 68 + 16 * bj + cc];
            SS[o] = s; }
        LDSW(); wg_sync();
        for (int o = tid; o < np_ * 256; o += 512) { const int p = o >> 8, rr = (o >> 4) & 15, cc = o & 15, bj = p, bi = p + Lv; float s = 0.f;
#pragma unroll
            for (int m = 0; m < 16; ++m) s += TF[(16 * bi + rr) * 68 + 16 * bi + m] * SS[p * 256 + m * 16 + cc];
            TF[(16 * bi + rr) * 68 + 16 * bj + cc] = -s; }
        LDSW(); wg_sync(); }
    for (int o = tid; o < 2048; o += 512) { const int i = o >> 5, j2 = (o & 31) * 2; if ((j2 >> 4) <= (i >> 4)) *(LAS unsigned*)(L + L_TB + i * 144 + j2 * 2) = cvtpk(TF[i * 68 + j2], TF[i * 68 + j2 + 1]); }
    LDSW(); wg_sync();
    { const int which = w >> 2, it = w & 3; f32x4 acc[8];
#pragma unroll
      for (int dt = 0; dt < 8; ++dt) { acc[dt] = (f32x4){0.f, 0.f, 0.f, 0.f}; acc[dt] = tile16(L + L_TB + 16 * it * 144, 144, L + (which ? L_GT : L_VT) + 16 * dt * 144, 144, 2, acc[dt], r, q); }
      LDSW(); wg_sync();
#pragma unroll
      for (int dt = 0; dt < 8; ++dt) { u32x2 o; o.x = cvtpk(acc[dt][0], acc[dt][1]); o.y = cvtpk(acc[dt][2], acc[dt][3]);
#if defined(DBG_O) && DBG_O == 1
          if (which)
#endif
          *(LAS u32x2*)(L + (which ? L_GT : L_VT) + (16 * dt + r) * 144 + (16 * it + 4 * q) * 2) = o; } }
    LDSW(); wg_sync();
    { bf16* Ap = F_AP + (size_t)item * 16384; bf16* BnT = F_BNT + (size_t)item * 16384; bf16* Qe = F_QEFF + (size_t)item * 8192; bf16* Oi = F_OIN + (size_t)item * 8192;
#pragma unroll
      for (int d2t = 0; d2t < 8; ++d2t) { f32x4 acc = (f32x4){0.f, 0.f, 0.f, 0.f}; acc = tile16(L + L_GT + 16 * d2t * 144, 144, L + L_DT + 16 * w * 144, 144, 2, acc, r, q);
          u32x2 o; o.x = cvtpk(-acc[0], -acc[1]); o.y = cvtpk(-acc[2], -acc[3]);
          *(GAS u32x2*)(Ap + (((w * 4 + (d2t >> 1)) * 64 + ((d2t & 1) * 2 + (q >> 1)) * 16 + r) * 8 + 4 * (q & 1))) = o; }
#pragma unroll
      for (int d1t = 0; d1t < 8; ++d1t) { f32x4 acc = (f32x4){0.f, 0.f, 0.f, 0.f}; acc = tile16(L + L_DT + 16 * d1t * 144, 144, L + L_VT + 16 * w * 144, 144, 2, acc, r, q);
          u32x2 o; o.x = cvtpk(acc[0], acc[1]); o.y = cvtpk(acc[2], acc[3]); *(GAS u32x2*)(BnT + (16 * w + r) * 128 + 16 * d1t + 4 * q) = o; }
      { const int it = w & 3, dh = w >> 2, i = 16 * it + r; const float eg = __expf(gcs[i]);
#pragma unroll
        for (int dd = 0; dd < 4; ++dd) { const int dt = 4 * dh + dd, dc = 16 * dt + 4 * q;
            f32x4 a1 = (f32x4){0.f, 0.f, 0.f, 0.f}, a2 = a1;
            a1 = tile16(L + L_GT + 16 * dt * 144, 144, L + L_AI + 16 * it * 144, 144, 2, a1, r, q);
            a2 = tile16(L + L_VT + 16 * dt * 144, 144, L + L_AI + 16 * it * 144, 144, 2, a2, r, q);
            const u32x2 qv = *(const LAS u32x2*)(L + L_QB + i * 272 + dc * 2);
            u32x2 o; o.x = cvtpk(bflo(qv.x) * eg - a1[0], bfhi(qv.x) * eg - a1[1]); o.y = cvtpk(bflo(qv.y) * eg - a1[2], bfhi(qv.y) * eg - a1[3]);
            *(GAS u32x2*)(Qe + i * 128 + dc) = o;
#if defined(DBG_O)
            { float vv[4];
#pragma unroll
              for (int j = 0; j < 4; ++j) vv[j] = bf1(*(const LAS unsigned short*)(L + L_VT + (dc + j) * 144 + i * 2));
              a2 = (f32x4){vv[0], vv[1], vv[2], vv[3]}; }
#endif
            o.x = cvtpk(a2[0], a2[1]); o.y = cvtpk(a2[2], a2[3]); *(GAS u32x2*)(Oi + i * 128 + dc) = o; } } }
    wg_sync();
    { constexpr int L_XM = 0, L_XB = 107520;
      const float egc = __expf(gcs[63]);
      if (j > 0) {
#pragma unroll
          for (int et = 0; et < 16; ++et) { u32x2 o; o.x = cvtpk(X[et][0], X[et][1]); o.y = cvtpk(X[et][2], X[et][3]);
              *(LAS u32x2*)(L + (et < 8 ? L_XM : L_XB) + (16 * (et & 7) + r) * 272 + (16 * w + 4 * q) * 2) = o; }
          LDSW(); wg_sync();
          bf16x8 af[4];
#pragma unroll
          for (int ks = 0; ks < 4; ++ks) { f32x4 ta = (f32x4){0.f, 0.f, 0.f, 0.f}, tb = ta;
              ta = tile16(L + L_GT + 16 * (2 * ks) * 144, 144, L + L_DT + 16 * w * 144, 144, 2, ta, r, q); tb = tile16(L + L_GT + 16 * (2 * ks + 1) * 144, 144, L + L_DT + 16 * w * 144, 144, 2, tb, r, q);
              v4u pw; pw.x = cvtpk(-ta[0], -ta[1]); pw.y = cvtpk(-ta[2], -ta[3]); pw.z = cvtpk(-tb[0], -tb[1]); pw.w = cvtpk(-tb[2], -tb[3]); af[ks] = __builtin_bit_cast(bf16x8, pw); }
#pragma unroll
          for (int et = 0; et < 16; ++et) { f32x4 add = (f32x4){0.f, 0.f, 0.f, 0.f};
              if (et < 8) { add = tile16(L + L_DT + 16 * w * 144, 144, L + L_GT + 16 * et * 144, 144, 2, add, r, q); add = add * (-sigma); }
              else add = tile16(L + L_DT + 16 * w * 144, 144, L + L_VT + 16 * (et - 8) * 144, 144, 2, add, r, q);
              f32x4 c = X[et] * egc + add;
              const LAS unsigned char* xp = L + (et < 8 ? L_XM : L_XB) + (16 * (et & 7) + r) * 272 + 8 * q;
#pragma unroll
              for (int ks = 0; ks < 4; ++ks) { const u32x2 lo = *(const LAS u32x2*)(xp + 64 * ks), hi = *(const LAS u32x2*)(xp + 64 * ks + 32);
                  v4u bv; bv.x = lo.x; bv.y = lo.y; bv.z = hi.x; bv.w = hi.y; c = MFMA16(af[ks], __builtin_bit_cast(bf16x8, bv), c); }
              X[et] = c; }
          sigma *= egc;
      } else {
#pragma unroll
          for (int et = 0; et < 16; ++et) { f32x4 add = (f32x4){0.f, 0.f, 0.f, 0.f};
              if (et < 8) { add = tile16(L + L_DT + 16 * w * 144, 144, L + L_GT + 16 * et * 144, 144, 2, add, r, q); add = -add; }
              else add = tile16(L + L_DT + 16 * w * 144, 144, L + L_VT + 16 * (et - 8) * 144, 144, 2, add, r, q);
              X[et] = add; }
          sigma = egc;
      }
    }
    LDSW(); wg_sync();
}
DI void dngroup_finish(Frame& F, int grp, const f32x4 (&X)[16], float sigma) {
    const int lane = F.lane, w = F.wave, r = lane & 15, q = lane >> 4; LAS unsigned char* L = F.lds;
    bf16* Bc = F_BCT + (size_t)grp * 16384;
#pragma unroll
    for (int et = 0; et < 8; ++et) { u32x2 o; o.x = cvtpk(X[8 + et][0], X[8 + et][1]); o.y = cvtpk(X[8 + et][2], X[8 + et][3]); *(GAS u32x2*)(Bc + (16 * et + r) * 128 + 16 * w + 4 * q) = o;
        o.x = cvtpk(X[et][0], X[et][1]); o.y = cvtpk(X[et][2], X[et][3]); *(LAS u32x2*)(L + (16 * et + r) * 272 + (16 * w + 4 * q) * 2) = o; }
    LDSW(); wg_sync();
    bf16* Ag = F_APG + (size_t)grp * 16384;
#pragma unroll
    for (int ks = 0; ks < 4; ++ks) { unsigned short e[8];
#pragma unroll
        for (int jj = 0; jj < 8; ++jj) e[jj] = *(const LAS unsigned short*)(L + (32 * ks + 8 * q + jj) * 272 + (16 * w + r) * 2);
        v4u o; o.x = e[0] | ((unsigned)e[1] << 16); o.y = e[2] | ((unsigned)e[3] << 16); o.z = e[4] | ((unsigned)e[5] << 16); o.w = e[6] | ((unsigned)e[7] << 16);
        *(GAS v4u*)(Ag + ((w * 4 + ks) * 64 + lane) * 8) = o; }
    if (F.tid == 0) F_GLXG[grp] = sigma;
    LDSW(); wg_sync();
}

struct ScanSet { bf16x8 af[4]; u32x2 bn[2]; float eg; };
DI void scan_load(Frame& F, ScanSet& s, int item, int w, int e0, int lane, int r, int q, int zlane) {
    const bf16* Ap = F_APG + (size_t)item * 16384 + (size_t)(w * 4) * 512 + lane * 8;
#pragma unroll
    for (int ks = 0; ks < 4; ++ks) s.af[ks] = *(const GAS bf16x8*)(Ap + ks * 512);
    const bf16* BnT = F_BCT + (size_t)item * 16384 + (size_t)(e0 + r) * 128 + 16 * w + 4 * q;
    s.bn[0] = *(const GAS u32x2*)BnT; s.bn[1] = *(const GAS u32x2*)(BnT + 16 * 128);
    s.eg = F_GLXG[item + zlane];
}
DI void scan_step(Frame& F, const ScanSet& s, f32x4 (&acc)[2], int item, int buf, int w, int e0, int r, int q) {
    LAS unsigned char* ST = F.lds + buf * 8704;
    bf16* Sg = F_SGRP + (size_t)item * 16384 + (size_t)(e0 + r) * 128 + 16 * w + 4 * q;
#pragma unroll
    for (int et = 0; et < 2; ++et) { u32x2 o; o.x = cvtpk(acc[et][0], acc[et][1]); o.y = cvtpk(acc[et][2], acc[et][3]);
        *(LAS u32x2*)(ST + (16 * et + r) * 272 + (16 * w + 4 * q) * 2) = o; *(GAS u32x2*)(Sg + et * 16 * 128) = o; }
    LDSW(); __builtin_amdgcn_s_barrier(); asm volatile("" ::: "memory");
    bf16x8 bfr[2][4];
#pragma unroll
    for (int et = 0; et < 2; ++et)
#pragma unroll
        for (int ks = 0; ks < 4; ++ks) bfr[et][ks] = *(const LAS bf16x8*)(ST + (16 * et + r) * 272 + 64 * ks + 16 * q);
#pragma unroll
    for (int et = 0; et < 2; ++et) { f32x4 c;
        c[0] = acc[et][0] * s.eg + bflo(s.bn[et].x); c[1] = acc[et][1] * s.eg + bfhi(s.bn[et].x); c[2] = acc[et][2] * s.eg + bflo(s.bn[et].y); c[3] = acc[et][3] * s.eg + bfhi(s.bn[et].y);
#pragma unroll
        for (int ks = 0; ks < 4; ++ks) c = MFMA16(s.af[ks], bfr[et][ks], c);
        acc[et] = c; }
}
DI void scan_slice(Frame& F, int h, int slice) {
    const int lane = F.lane, w = F.wave, r = lane & 15, q = lane >> 4, e0 = 32 * slice, i0 = h * 32;
    f32x4 acc[2] = {(f32x4){0.f, 0.f, 0.f, 0.f}, (f32x4){0.f, 0.f, 0.f, 0.f}};
    ScanSet s0, s1, s2, s3;
    int zlane = 0; asm volatile("" : "+v"(zlane));
    scan_load(F, s0, i0, w, e0, lane, r, q, zlane); scan_load(F, s1, i0 + 1, w, e0, lane, r, q, zlane); scan_load(F, s2, i0 + 2, w, e0, lane, r, q, zlane);
    for (int n = 0; n < 32; n += 4) {
        scan_load(F, s3, i0 + n + 3, w, e0, lane, r, q, zlane);
        scan_step(F, s0, acc, i0 + n, 0, w, e0, r, q);
        if (n + 4 < 32) scan_load(F, s0, i0 + n + 4, w, e0, lane, r, q, zlane);
        scan_step(F, s1, acc, i0 + n + 1, 1, w, e0, r, q);
        if (n + 4 < 32) scan_load(F, s1, i0 + n + 5, w, e0, lane, r, q, zlane);
        scan_step(F, s2, acc, i0 + n + 2, 0, w, e0, r, q);
        if (n + 4 < 32) scan_load(F, s2, i0 + n + 6, w, e0, lane, r, q, zlane);
        scan_step(F, s3, acc, i0 + n + 3, 1, w, e0, r, q);
    }
    LDSW(); wg_sync();
}

DI void dnout_group(Frame& F, int grp) {
    int lane_ = F.lane, tid_ = F.tid; asm volatile("" : "+v"(lane_), "+v"(tid_));
    const int h = grp >> 5, g = grp & 31, lane = lane_, tid = tid_, w = F.wave, r = lane & 15, q = lane >> 4;
    LAS unsigned char* L = F.lds; LAS unsigned char* ST = L + 65536 + w * 4352; LAS float* RED = (LAS float*)(L + 65536 + 34816);
    f32x4 acc[8];
    { const bf16* Sg = F_SGRP + (size_t)grp * 16384 + (16 * w + r) * 128 + 4 * q;
#pragma unroll
      for (int dt = 0; dt < 8; ++dt) { const u32x2 u = *(const GAS u32x2*)(Sg + 16 * dt); acc[dt] = (f32x4){bflo(u.x), bfhi(u.x), bflo(u.y), bfhi(u.y)}; } }
#pragma unroll 1
    for (int j = 0; j < 4; ++j) { const int item = h * 128 + 4 * g + j, t0 = 64 * (4 * g + j); LAS unsigned char* AL = L + (j & 1) * 32768;
        v4u ar[4];
        if (j < 3) { const bf16* Ap = F_AP + (size_t)item * 16384;
#pragma unroll
            for (int i = 0; i < 4; ++i) ar[i] = *(const GAS v4u*)(Ap + (size_t)(tid + 512 * i) * 8); }
#pragma unroll
        for (int dt = 0; dt < 8; ++dt) { u32x2 o; o.x = cvtpk(acc[dt][0], acc[dt][1]); o.y = cvtpk(acc[dt][2], acc[dt][3]); *(LAS u32x2*)(ST + r * 272 + (16 * dt + 4 * q) * 2) = o; }
        if (j < 3) {
#pragma unroll
            for (int i = 0; i < 4; ++i) *(LAS v4u*)(AL + (tid + 512 * i) * 16) = ar[i]; }
        LDSW(); wg_sync();
        bf16x8 sf[4];
#pragma unroll
        for (int ks = 0; ks < 4; ++ks) sf[ks] = *(const LAS bf16x8*)(ST + r * 272 + 64 * ks + 16 * q);
        f32x4 o[4];
        { const bf16* Qe = F_QEFF + (size_t)item * 8192 + r * 128 + 8 * q; const bf16* Oi = F_OIN + (size_t)item * 8192 + r * 128 + 16 * w + 4 * q;
#pragma unroll
          for (int it = 0; it < 4; ++it) { const u32x2 oi = *(const GAS u32x2*)(Oi + it * 2048); f32x4 c = (f32x4){bflo(oi.x), bfhi(oi.x), bflo(oi.y), bfhi(oi.y)};
#pragma unroll
              for (int ks = 0; ks < 4; ++ks) { const bf16x8 bq = *(const GAS bf16x8*)(Qe + it * 2048 + 32 * ks); c = MFMA16(sf[ks], bq, c); }
              o[it] = c; float ss = (c[0] * c[0] + c[1] * c[1]) + (c[2] * c[2] + c[3] * c[3]); ss += __shfl_xor(ss, 16); ss += __shfl_xor(ss, 32);
              if (q == 0) RED[(16 * it + r) * 8 + w] = ss; } }
        LDSW(); wg_sync();
        { const f32x4 gg = *(const GAS f32x4*)(F_dn_g + 16 * w + 4 * q);
#pragma unroll
          for (int it = 0; it < 4; ++it) { const f32x4 p0 = *(const LAS f32x4*)(RED + (16 * it + r) * 8), p1 = *(const LAS f32x4*)(RED + (16 * it + r) * 8 + 4);
              const float tot = ((p0[0] + p0[1]) + (p0[2] + p0[3])) + ((p1[0] + p1[1]) + (p1[2] + p1[3])); const float rs = 1.f / sqrtf(tot * (1.f / 128.f) + EPSF);
              const int t = t0 + 16 * it + r; const u32x2 z = *(const GAS u32x2*)(F_P + (size_t)t * PLD + PC_DZ + 128 * h + 16 * w + 4 * q);
              u32x2 ov; ov.x = cvtpk(o[it][0] * rs * gg[0] * silu_f(bflo(z.x)), o[it][1] * rs * gg[1] * silu_f(bfhi(z.x))); ov.y = cvtpk(o[it][2] * rs * gg[2] * silu_f(bflo(z.y)), o[it][3] * rs * gg[3] * silu_f(bfhi(z.y)));
              *(GAS u32x2*)(F_MIXED + (size_t)t * DM + MC_B + 128 * h + 16 * w + 4 * q) = ov; } }
        if (j < 3) { const float eg = F_GLX[item]; const bf16* BnT = F_BNT + (size_t)item * 16384 + (16 * w + r) * 128 + 4 * q;
#pragma unroll
            for (int dt = 0; dt < 8; ++dt) { const u32x2 bn = *(const GAS u32x2*)(BnT + 16 * dt); f32x4 c;
                c[0] = acc[dt][0] * eg + bflo(bn.x); c[1] = acc[dt][1] * eg + bfhi(bn.x); c[2] = acc[dt][2] * eg + bflo(bn.y); c[3] = acc[dt][3] * eg + bfhi(bn.y);
#pragma unroll
                for (int ks = 0; ks < 4; ++ks) { const bf16x8 a = *(const LAS bf16x8*)(AL + ((dt * 4 + ks) * 64 + lane) * 16); c = MFMA16(a, sf[ks], c); }
                acc[dt] = c; } }
    }
    LDSW(); wg_sync();
}
DI void final_row(float* row, const float* g, int lane) {
    GAS f32x4* xr = (GAS f32x4*)row + lane; f32x4 v[8]; float s = 0.f;
#pragma unroll
    for (int j = 0; j < 8; ++j) { v[j] = xr[64 * j]; s += (v[j].x * v[j].x + v[j].y * v[j].y) + (v[j].z * v[j].z + v[j].w * v[j].w); }
    const float rs = 1.f / sqrtf(wave_sum(s) * (1.f / DM) + EPSF);
#pragma unroll
    for (int j = 0; j < 8; ++j) { const f32x4 gg = ((const GAS f32x4*)g)[64 * j + lane]; xr[64 * j] = v[j] * rs * gg; }
}
struct Args { const float* in[16]; float* out; unsigned char* ws; int ph_lo, ph_hi, li, pad; };
__global__ void __launch_bounds__(NWAVES * 64, 2) fwd_kernel(Args args) {
    extern __shared__ __attribute__((aligned(16))) unsigned char lds[];
    Frame F;
    F.lds = (LAS unsigned char*)lds; F.MISC = (volatile LAS unsigned*)(F.lds + MISC_OFF);
    F.tid = threadIdx.x; F.lane = F.tid & 63; F.wave = __builtin_amdgcn_readfirstlane(F.tid >> 6);
    F.G = gridDim.x; { const int bx = blockIdx.x; F.vcu = (F.G % 8 == 0) ? (bx % 8) * (F.G / 8) + bx / 8 : bx; }
    F.ws = args.ws; F.out = args.out;
    F.inp = (const float* const*)__builtin_amdgcn_kernarg_segment_ptr();
    for (int u = F.tid; u < (LDS_BYTES - LDSCTL_OFF) / 4; u += NWAVES * 64) ((LAS unsigned*)(F.lds + LDSCTL_OFF))[u] = 0u;
    __syncthreads();
    XcdBarrier bar; bar.bar = (unsigned*)(F_ctl + CW_BAR); bar.x = 0; bar.st = nullptr;
    if (N_LAUNCHES == 1) bar = xcd_barrier_post((unsigned*)(F_ctl + CW_BAR), F.MISC + 8);
#define GRID_BAR() do { if (N_LAUNCHES == 1) xcd_barrier(bar); } while (0)
    const int lo = args.ph_lo, hi = args.ph_hi;
#if defined(DBG_TS_I)
    volatile unsigned long long* tsw = (volatile unsigned long long*)(F.ws + 512 * 1024);
    const bool stamper = (blockIdx.x == 0 && threadIdx.x == 0);
    if (stamper) tsw[15] = __builtin_amdgcn_s_memrealtime();
#define STAMP(k) do { if (stamper) tsw[k] = __builtin_amdgcn_s_memrealtime(); } while (0)
#else
#define STAMP(k) do {} while (0)
#endif
#ifndef ITEM_MASK
#define ITEM_MASK 7
#endif
#ifndef PH_MASK
#define PH_MASK 0x7f
#endif
#define IN(k) (((PH_MASK >> (k)) & 1) && lo <= (k) && (k) < hi)
#define BOTH(k) (IN(k) && IN((k) + 1))
#ifndef REP_MASK
#define REP_MASK 0
#endif
#define REPS(k) for (int rep_ = 0; rep_ <= ((REP_MASK >> (k)) & 1); ++rep_)
#define REFRESH() do { int t_ = threadIdx.x; asm volatile("" : "+v"(t_)); F.tid = t_; F.lane = t_ & 63; } while (0)
    if (IN(0)) REPS(0) { REFRESH(); p0_prologue(F); if (BOTH(0)) GRID_BAR(); STAMP(0); }
    if (IN(1)) REPS(1) {
        pg8::Gemm g{F_XB, F_WTIN, SEQ + NMEMT, NPADC + 1024, DM}; pg8::Order1 S; S.init(F.G, (int)blockIdx.x);
        pg8::EpiProj E{F_P, F_AB, F_RSTD, F_MKV};
        pg8::gemm_phase<pg8::EpiProj, pg8::Order1, true, true>(F.lds, g, S, E);
        if (BOTH(1)) GRID_BAR(); STAMP(1);
    }
    if (IN(2)) REPS(2) {
        REFRESH();
        if (ITEM_MASK & 1) for (int grp = F.vcu; grp < 256; grp += F.G) { f32x4 X[16]; float sigma = 1.f;
#pragma unroll
            for (int et = 0; et < 16; ++et) X[et] = (f32x4){0.f, 0.f, 0.f, 0.f};
#pragma unroll 1
            for (int j = 0; j < 4; ++j) dnprep_item(F, (grp >> 5) * 128 + (grp & 31) * 4 + j, X, sigma, j);
            dngroup_finish(F, grp, X, sigma); }
        if (ITEM_MASK & 2) for (int it = F.vcu; it < 256; it += F.G) gmlp_item(F, it);
        if (ITEM_MASK & 4) for (int it = F.vcu; it < 256; it += F.G) xattn_item(F, it);
        if (BOTH(2)) GRID_BAR(); STAMP(2);
    }
    if (IN(3)) REPS(3) { REFRESH(); if (blockIdx.x < 32) scan_slice(F, (int)blockIdx.x & 7, (int)blockIdx.x >> 3); if (BOTH(3)) GRID_BAR(); STAMP(3); }
    if (IN(4)) REPS(4) { REFRESH(); for (int grp = F.vcu; grp < 256; grp += F.G) dnout_group(F, grp); if (BOTH(4)) GRID_BAR(); STAMP(4); }
    if (IN(5)) REPS(5) {
        pg8::Gemm g{F_MIXED, F_WTOUT, SEQ, DM, DM}; pg8::StaticOrder S; S.init(SEQ, DM, F.G, (int)blockIdx.x);
        pg8::EpiRes E{F_x, F.out};
        pg8::gemm_phase<pg8::EpiRes, pg8::StaticOrder, true, true>(F.lds, g, S, E);
        if (BOTH(5)) GRID_BAR(); STAMP(5);
    }
    if (IN(6)) { REFRESH(); const int gw = F.vcu * NWAVES + F.wave, NGW = F.G * NWAVES; for (int m = gw; m < SEQ; m += NGW) final_row(F.out + (size_t)m * DM, F_final_g, F.lane);
#if defined(DBG_TS_I)
        if (stamper) { const float vi = (float)(tsw[DBG_TS_I] - tsw[15]) * 0.01f, vj = (float)(tsw[DBG_TS_J] - tsw[15]) * 0.01f; F.out[0] += vj; for (int j = 1; j < 8; ++j) { F.out[256 * j] += vi; F.out[256 * j + 1] += vi; F.out[256 * j + 2] += vi; F.out[256 * j + 3] += vi; } }
#endif
    }
#undef IN
#undef BOTH
}

extern "C" void kernel_launch(void* const* d_in, const int* in_sizes, int n_in, void* d_out, int out_size, void* d_ws, size_t ws_size, hipStream_t stream) {
    static int grid = 0;
    if (grid == 0) {
        if (n_in != 16 || in_sizes[0] != SEQ * DM || out_size != SEQ * DM || ws_size < WS_END) { fprintf(stderr, "kernel_launch: unexpected shapes (n_in %d, in0 %d, out %d, ws %zu); nothing launched\n", n_in, n_in > 0 ? in_sizes[0] : -1, out_size, ws_size); grid = -1; return; }
        int dev = 0, cus = 0, per_cu = 0;
        if (hipGetDevice(&dev) != hipSuccess || hipDeviceGetAttribute(&cus, hipDeviceAttributeMultiprocessorCount, dev) != hipSuccess) { grid = -1; return; }
        if (hipFuncSetAttribute((const void*)fwd_kernel, hipFuncAttributeMaxDynamicSharedMemorySize, LDS_BYTES) != hipSuccess) { fprintf(stderr, "kernel_launch: hipFuncSetAttribute failed\n"); grid = -1; return; }
        if (hipOccupancyMaxActiveBlocksPerMultiprocessor(&per_cu, (const void*)fwd_kernel, NWAVES * 64, LDS_BYTES) != hipSuccess || per_cu < 1) fprintf(stderr, "kernel_launch: note: occupancy query reports %d\n", per_cu);
        (void)hipGetLastError();
        grid = cus;
    }
    if (grid < 0) return;
    if (hipMemsetAsync((char*)d_ws + WS_CTL, 0, CTL_ZERO_BYTES, stream) != hipSuccess) return;
    Args a{};
    for (int i = 0; i < 16; ++i) a.in[i] = (const float*)d_in[i];
    a.out = (float*)d_out; a.ws = (unsigned char*)d_ws;
    for (int li = 0; li < N_LAUNCHES; ++li) {
        a.ph_lo = (N_LAUNCHES == 1) ? 0 : li; a.ph_hi = (N_LAUNCHES == 1) ? N_PHASES : li + 1; a.li = li;
        hipLaunchKernelGGL(fwd_kernel, dim3(grid), dim3(NWAVES * 64), LDS_BYTES, stream, a);
        if (hipPeekAtLastError() != hipSuccess) { fprintf(stderr, "kernel_launch: launch %d failed\n", li); break; }
    }
}
```

```cpp
#include <hip/hip_runtime.h>
#include <cstdio>
#include <cstdint>
#ifndef MK_N_LAUNCHES
#define MK_N_LAUNCHES 1
#endif
namespace pg8 {
#define PG8_LAS __attribute__((address_space(3)))
typedef unsigned short bf16_t;
typedef short bf16x8 __attribute__((ext_vector_type(8)));
typedef float f32x4 __attribute__((ext_vector_type(4)));
typedef unsigned u32x4 __attribute__((ext_vector_type(4)));
constexpr int BM = 256, BK = 64, HALF = 128, HTB = HALF * BK * 2  , STAGE_BYTES = 8 * HTB, NXCD = 8, WGM = 8;

__host__ __device__ __forceinline__ int lds_byte(int r, int c) { const int st = (r >> 4) * 2 + (c >> 5), rr = r & 15, cc = c & 31, ob = rr * 64 + cc * 2; return st * 1024 + (ob ^ (((ob >> 9) & 1) << 5)); }
__host__ __device__ __forceinline__ void stage_rc(int b, int& R, int& C) { const int st = b / 1024, sb = b % 1024, swz = sb ^ (((sb >> 9) & 1) << 5); R = (st >> 1) * 16 + swz / 64; C = (st & 1) * 32 + (swz % 64) / 2; }
__host__ __device__ __forceinline__ int perm32(int rho) { const int n = rho >> 4, i = rho & 15; return 8 * (i >> 2) + 4 * n + (i & 3); }

struct Unit { int pm, pn; };
struct Gemm { const bf16_t* A; const bf16_t* Bt; int M, N, K; };

struct StaticOrder {
    int nM, nN, nwg, G, c;
    __host__ __device__ void init(int M, int N, int G_, int c_) { nM = M / BM; nN = N / BM; nwg = nM * nN; G = G_; c = c_; }
    __host__ __device__ bool next(int i, Unit& u) const {
        const long L = (long)i * G + c; if (L >= nwg) return false;
        int wgid = (int)L; { const int q = nwg / NXCD, r = nwg % NXCD, xcd = wgid % NXCD, off = wgid / NXCD; wgid = (xcd < r ? xcd * (q + 1) : r * (q + 1) + (xcd - r) * q) + off; }
        const int nig = WGM * nN, gid = wgid / nig, fm = gid * WGM, gsz = (nM - fm) < WGM ? (nM - fm) : WGM;
        u.pm = fm + ((wgid % nig) % gsz); u.pn = (wgid % nig) / gsz; return true;
    }
    __device__ __forceinline__ void a_ready(const Unit&) const {}
    __device__ __forceinline__ void done(const Unit&) const {}
};

__device__ __forceinline__ unsigned cvt_pk_bf16(float lo, float hi) { unsigned r; asm volatile("v_cvt_pk_bf16_f32 %0, %1, %2" : "=v"(r) : "v"(lo), "v"(hi)); return r; }
struct EpiProj {
    static constexpr bool PERM = true, AFTER_DRAIN = false;
    bf16_t* P; float* AB; const float* rstd; bf16_t* MKV;
    __device__ __forceinline__ void operator()(const f32x4 (&acc)[2][2][4][2], const Unit& u, int wr, int wc, int fr, int fq) const {
        const int row0 = wr * 64 + fr; const bool memt = u.pm >= 32;
        const float* rsp = rstd + (memt ? 0 : u.pm * BM);
        if (u.pn != 26) {
            bf16_t* base = memt ? MKV + (size_t)(u.pn - 27) * BM : P + (size_t)u.pm * BM * 6656 + (size_t)u.pn * BM; const int ldc = memt ? 1024 : 6656;
            base += wc * 32 + 8 * fq;
#pragma unroll
            for (int ai = 0; ai < 2; ++ai)
#pragma unroll
                for (int m = 0; m < 4; ++m) { const int row = row0 + ai * HALF + m * 16; const float rs = memt ? 1.f : rsp[row]; bf16_t* rowp = base + (size_t)row * ldc;
#pragma unroll
                    for (int bj = 0; bj < 2; ++bj) { const f32x4 v0 = acc[ai][bj][m][0] * rs, v1 = acc[ai][bj][m][1] * rs;
                        u32x4 w; w.x = cvt_pk_bf16(v0[0], v0[1]); w.y = cvt_pk_bf16(v0[2], v0[3]); w.z = cvt_pk_bf16(v1[0], v1[1]); w.w = cvt_pk_bf16(v1[2], v1[3]);
                        *(u32x4*)(rowp + bj * HALF) = w; } }
        } else if (wc == 0 && fq < 2) {
#pragma unroll
            for (int ai = 0; ai < 2; ++ai)
#pragma unroll
                for (int m = 0; m < 4; ++m) { const int row = row0 + ai * HALF + m * 16; const float rs = rsp[row];
#pragma unroll
                    for (int n = 0; n < 2; ++n) *(f32x4*)(AB + (size_t)(u.pm * BM + row) * 16 + 8 * fq + 4 * n) = acc[ai][0][m][n] * rs; }
        }
    }
};
struct EpiRes {
    static constexpr bool PERM = false, AFTER_DRAIN = false;
    const float* X; float* O;
    __device__ __forceinline__ void operator()(const f32x4 (&acc)[2][2][4][2], const Unit& u, int wr, int wc, int fr, int fq) const {
        const int row0 = u.pm * BM + wr * 64 + fr, col0 = u.pn * BM + wc * 32 + 4 * fq;
#pragma unroll
        for (int ai = 0; ai < 2; ++ai)
#pragma unroll
            for (int m = 0; m < 4; ++m) { const size_t off = (size_t)(row0 + ai * HALF + m * 16) * 2048 + col0;
#pragma unroll
                for (int bj = 0; bj < 2; ++bj)
#pragma unroll
                    for (int n = 0; n < 2; ++n) { const f32x4 xv = *(const f32x4*)(X + off + bj * HALF + n * 16); *(f32x4*)(O + off + bj * HALF + n * 16) = xv + acc[ai][bj][m][n]; } }
    }
};
struct Order1 {
    StaticOrder so; int G, c;
    __device__ void init(int G_, int c_) { so.init(8192, 6912, G_, c_); G = G_; c = c_; }
    __device__ bool next(int i, Unit& u) const { const long L = (long)i * G + c; if (L < 864) return so.next(i, u); if (L < 868) { u.pm = 32; u.pn = 27 + (int)(L - 864); return true; } return false; }
    __device__ __forceinline__ void a_ready(const Unit&) const {}
    __device__ __forceinline__ void done(const Unit&) const {}
};
template <class Epi, class Sched, bool ALIGN_EPI = false, bool SP2 = false>
__device__ __forceinline__ void gemm_phase(PG8_LAS unsigned char* lds, const Gemm g, const Sched& S, const Epi& E) {
    const int tid = threadIdx.x, wid = __builtin_amdgcn_readfirstlane(tid >> 6), lane = tid & 63, wr = wid >> 2, wc = wid & 3, fr = lane & 15, fq = lane >> 4;
    const int K = g.K, nt = K / BK;
    unsigned voffA[2], voffB[2];
#pragma unroll
    for (int i = 0; i < 2; ++i) { int R, C; stage_rc(tid * 16 + i * 8192, R, C); const int Rb = Epi::PERM ? ((R & ~31) + perm32(R & 31)) : R;
        voffA[i] = (unsigned)(R * K + C) * 2u; voffB[i] = (unsigned)(Rb * K + C) * 2u; }
    const size_t kstep = (size_t)(BK * 2);
    const size_t hstep = (size_t)HALF * K * 2;
    const size_t tstep = 2 * hstep;
    const unsigned ldsw = (unsigned)wid * 1024u;
    const int aoff = lds_byte(wr * 64 + fr, fq * 8), boff = lds_byte(wc * 32 + fr, fq * 8);
#define PG8_SA(b, h) (((b) * 2 + (h)) * HTB)
#define PG8_SB(b, h) ((4 + (b) * 2 + (h)) * HTB)
#define PG8_STAGE(bufoff, gbase, voff) do { _Pragma("unroll") for (int _i = 0; _i < 2; ++_i) \
        __builtin_amdgcn_global_load_lds((const unsigned*)((const char*)(gbase) + (voff)[_i]), (PG8_LAS unsigned*)(lds + (bufoff) + ldsw + _i * 8192), 16, 0, 0); } while (0)
#define PG8_LDA(dst, b, h) do { _Pragma("unroll") for (int m = 0; m < 4; ++m) _Pragma("unroll") for (int k = 0; k < 2; ++k) dst[m][k] = *(const PG8_LAS bf16x8*)(lds + PG8_SA(b, h) + aoff + m * 2048 + k * 1024); } while (0)
#define PG8_LDB(dst, b, h) do { _Pragma("unroll") for (int n = 0; n < 2; ++n) _Pragma("unroll") for (int k = 0; k < 2; ++k) dst[n][k] = *(const PG8_LAS bf16x8*)(lds + PG8_SB(b, h) + boff + n * 2048 + k * 1024); } while (0)
#define PG8_MMA(ai, bj, At, Bt) do { __builtin_amdgcn_s_setprio(1); _Pragma("unroll") for (int m = 0; m < 4; ++m) _Pragma("unroll") for (int n = 0; n < 2; ++n) _Pragma("unroll") for (int k = 0; k < 2; ++k) \
        acc[ai][bj][m][n] = __builtin_amdgcn_mfma_f32_16x16x32_bf16(Bt[n][k], At[m][k], acc[ai][bj][m][n], 0, 0, 0); __builtin_amdgcn_s_setprio(0); } while (0)
#define PG8_WAIT_V(n) asm volatile("s_waitcnt vmcnt(" #n ")" ::: "memory")
#define PG8_WAIT_L(n) asm volatile("s_waitcnt lgkmcnt(" #n ")" ::: "memory")
#define PG8_BAR __builtin_amdgcn_s_barrier()
#define PG8_SCHED __builtin_amdgcn_sched_barrier(0)
    Unit cur, nxt; int ui = 0;
    if (!S.next(0, cur)) return;
    f32x4 acc[2][2][4][2];
#pragma unroll
    for (int a = 0; a < 2; ++a)
#pragma unroll
        for (int b = 0; b < 2; ++b)
#pragma unroll
            for (int m = 0; m < 4; ++m)
#pragma unroll
                for (int n = 0; n < 2; ++n) acc[a][b][m][n] = (f32x4){0.f, 0.f, 0.f, 0.f};
    bf16x8 At[4][2], B0[2][2], B1[2][2];
    const char* cA = (const char*)g.A + (size_t)cur.pm * tstep; const char* cB = (const char*)g.Bt + (size_t)cur.pn * tstep;
    S.a_ready(cur);
    if constexpr (SP2) {
        PG8_STAGE(PG8_SB(0, 0), cB, voffB); PG8_STAGE(PG8_SB(0, 1), cB + hstep, voffB); PG8_STAGE(PG8_SA(0, 0), cA, voffA); PG8_STAGE(PG8_SA(0, 1), cA + hstep, voffA);
        if (wr == 1) PG8_BAR;
        PG8_WAIT_V(2); PG8_BAR;
        PG8_STAGE(PG8_SB(1, 0), cB + kstep, voffB); PG8_STAGE(PG8_SA(1, 0), cA + kstep, voffA); PG8_STAGE(PG8_SB(1, 1), cB + hstep + kstep, voffB);
        PG8_WAIT_V(6); PG8_BAR;
    } else {
        PG8_STAGE(PG8_SB(0, 0), cB, voffB); PG8_STAGE(PG8_SA(0, 0), cA, voffA); PG8_STAGE(PG8_SB(0, 1), cB + hstep, voffB); PG8_STAGE(PG8_SA(0, 1), cA + hstep, voffA);
        if (wr == 1) PG8_BAR;
        PG8_WAIT_V(4); PG8_BAR;
        PG8_STAGE(PG8_SB(1, 0), cB + kstep, voffB); PG8_STAGE(PG8_SA(1, 0), cA + kstep, voffA); PG8_STAGE(PG8_SB(1, 1), cB + hstep + kstep, voffB);
        PG8_WAIT_V(6); PG8_BAR;
    }
    for (;;) {
        const bool has_next = S.next(ui + 1, nxt);
        const char* nA = has_next ? (const char*)g.A + (size_t)nxt.pm * tstep : cA; const char* nB = has_next ? (const char*)g.Bt + (size_t)nxt.pn * tstep : cB;
        for (int t = 0; t < nt; t += 2) {
            const bool last = (t == nt - 2);
            const char* a1 = cA + (size_t)(t + 1) * kstep;
            const char* a2 = last ? nA : cA + (size_t)(t + 2) * kstep; const char* b2 = last ? nB : cB + (size_t)(t + 2) * kstep;
            const char* a3 = a2 + kstep; const char* b3 = b2 + kstep;
            if (last && has_next) S.a_ready(nxt);
            if constexpr (SP2) {
            PG8_LDB(B0, 0, 0); PG8_LDB(B1, 0, 1); PG8_SCHED; PG8_LDA(At, 0, 0); PG8_STAGE(PG8_SA(1, 1), a1 + hstep, voffA);
            PG8_WAIT_V(8); PG8_WAIT_L(0); PG8_BAR; PG8_MMA(0, 0, At, B0); PG8_MMA(0, 1, At, B1); PG8_BAR; PG8_SCHED;
            PG8_LDA(At, 0, 1); PG8_STAGE(PG8_SB(0, 0), b2, voffB); PG8_STAGE(PG8_SB(0, 1), b2 + hstep, voffB); PG8_STAGE(PG8_SA(0, 0), a2, voffA);
            PG8_WAIT_V(8); PG8_WAIT_L(0); PG8_BAR; PG8_MMA(1, 0, At, B0); PG8_MMA(1, 1, At, B1); PG8_BAR; PG8_SCHED;
            PG8_LDB(B0, 1, 0); PG8_LDB(B1, 1, 1); PG8_SCHED; PG8_LDA(At, 1, 0); PG8_STAGE(PG8_SA(0, 1), a2 + hstep, voffA);
            PG8_WAIT_V(8); PG8_WAIT_L(0); PG8_BAR; PG8_MMA(0, 0, At, B0); PG8_MMA(0, 1, At, B1); PG8_BAR; PG8_SCHED;
            PG8_LDA(At, 1, 1); PG8_STAGE(PG8_SB(1, 0), b3, voffB); PG8_STAGE(PG8_SB(1, 1), b3 + hstep, voffB); PG8_STAGE(PG8_SA(1, 0), a3, voffA);
            PG8_WAIT_V(8); PG8_WAIT_L(0); PG8_BAR; PG8_MMA(1, 0, At, B0); PG8_MMA(1, 1, At, B1); PG8_BAR; PG8_SCHED;
            } else {
            PG8_LDB(B0, 0, 0); PG8_SCHED; PG8_LDA(At, 0, 0); PG8_STAGE(PG8_SA(1, 1), a1 + hstep, voffA);
            PG8_WAIT_L(8); PG8_BAR; PG8_WAIT_L(0); PG8_MMA(0, 0, At, B0); PG8_BAR; PG8_SCHED;
            PG8_LDB(B1, 0, 1); PG8_STAGE(PG8_SB(0, 0), b2, voffB);
            PG8_BAR; PG8_WAIT_L(0); PG8_MMA(0, 1, At, B1); PG8_BAR;
            PG8_LDA(At, 0, 1); PG8_STAGE(PG8_SA(0, 0), a2, voffA);
            PG8_BAR; PG8_WAIT_L(0); PG8_MMA(1, 0, At, B0); PG8_BAR; PG8_SCHED;
            PG8_STAGE(PG8_SB(0, 1), b2 + hstep, voffB);
            PG8_WAIT_V(6); PG8_BAR; PG8_MMA(1, 1, At, B1); PG8_BAR;
            PG8_LDB(B0, 1, 0); PG8_SCHED; PG8_LDA(At, 1, 0); PG8_STAGE(PG8_SA(0, 1), a2 + hstep, voffA);
            PG8_WAIT_L(8); PG8_BAR; PG8_WAIT_L(0); PG8_MMA(0, 0, At, B0); PG8_BAR; PG8_SCHED;
            PG8_LDB(B1, 1, 1); PG8_STAGE(PG8_SB(1, 0), b3, voffB);
            PG8_BAR; PG8_WAIT_L(0); PG8_MMA(0, 1, At, B1); PG8_BAR;
            PG8_LDA(At, 1, 1); PG8_STAGE(PG8_SA(1, 0), a3, voffA);
            PG8_BAR; PG8_WAIT_L(0); PG8_MMA(1, 0, At, B0); PG8_BAR; PG8_SCHED;
            PG8_STAGE(PG8_SB(1, 1), b3 + hstep, voffB);
            PG8_WAIT_V(6); PG8_BAR; PG8_MMA(1, 1, At, B1); PG8_BAR;
            }
        }
        if constexpr (ALIGN_EPI) { if (wr == 0) PG8_BAR; }
        if constexpr (!Epi::AFTER_DRAIN) { E(acc, cur, wr, wc, fr, fq); S.done(cur); }
        if (!has_next) break;
#pragma unroll
        for (int a = 0; a < 2; ++a)
#pragma unroll
            for (int b = 0; b < 2; ++b)
#pragma unroll
                for (int m = 0; m < 4; ++m)
#pragma unroll
                    for (int n = 0; n < 2; ++n) acc[a][b][m][n] = (f32x4){0.f, 0.f, 0.f, 0.f};
        cur = nxt; cA = nA; cB = nB; ++ui;
        if constexpr (ALIGN_EPI) { if (wr == 1) PG8_BAR; }
    }
    PG8_WAIT_V(0);
    if constexpr (!ALIGN_EPI) { if (wr == 0) PG8_BAR; }
    PG8_BAR;
    if constexpr (Epi::AFTER_DRAIN) { E.fused(acc, cur, wr, wc, fr, fq, lds, wid, lane); S.done(cur); }
#undef PG8_SA
#undef PG8_SB
#undef PG8_STAGE
#undef PG8_LDA
#undef PG8_LDB
#undef PG8_MMA
#undef PG8_WAIT_V
#undef PG8_WAIT_L
#undef PG8_BAR
#undef PG8_SCHED
}
}
constexpr int NWAVES = 8;
constexpr int N_LAUNCHES = MK_N_LAUNCHES;
constexpr int N_PHASES = 7;
constexpr int SEQ = 8192, DM = 2048, NIN = 6672, NPADC = 6912, PLD = 6656, NMEMT = 256;
constexpr int PC_GU = 0, PC_GV = 512, PC_GZ = 1024, PC_DQ = 1536, PC_DK = 2560, PC_DV = 3584, PC_DZ = 4608, PC_CQ = 5632, PC_CZ = 6144;
constexpr int MC_A = 0, MC_B = 512, MC_C = 1536;
constexpr float EPSF = 1e-6f;
constexpr size_t MiB = 1u << 20;
constexpr size_t WS_CTL = 0, CTL_ZERO_BYTES = 1 * MiB;
constexpr size_t WS_XB = 2 * MiB;
constexpr size_t WS_WTIN = 36 * MiB;
constexpr size_t WS_WTOUT = 68 * MiB;
constexpr size_t WS_RSTD = 76 * MiB;
constexpr size_t WS_AB = 76 * MiB + 65536;
constexpr size_t WS_GLX = 76 * MiB + 655360;
constexpr size_t WS_GLXG = 76 * MiB + 659456;
constexpr size_t WS_MKV = 77 * MiB;
constexpr size_t WS_P = 78 * MiB;
constexpr size_t WS_MIXED = 182 * MiB;
constexpr size_t WS_APG = 214 * MiB;
constexpr size_t WS_BCT = 222 * MiB;
constexpr size_t WS_SGRP = 230 * MiB;
constexpr size_t WS_END = 246 * MiB;
constexpr size_t WS_AP = 2 * MiB;
constexpr size_t WS_BNT = 34 * MiB;
constexpr size_t OUT_QEFF = 0;
constexpr size_t OUT_OIN = 16 * MiB;
constexpr int CW_TMO = 0, CW_BAR = 4096;
constexpr int LDS_BYTES = 163840;
constexpr int LDSCTL_OFF = 162816, MISC_OFF = LDSCTL_OFF + 320;
#define GAS __attribute__((address_space(1)))
#define LAS __attribute__((address_space(3)))
typedef unsigned short bf16;
typedef unsigned v4u __attribute__((ext_vector_type(4)));
typedef float f32x4 __attribute__((ext_vector_type(4)));
typedef short bf16x8 __attribute__((ext_vector_type(8)));
typedef GAS unsigned gu32;
typedef GAS unsigned long long gu64;
#define RLX_AGENT __ATOMIC_RELAXED, __HIP_MEMORY_SCOPE_AGENT
#define LDS_WAIT() asm volatile("s_waitcnt lgkmcnt(0)" ::: "memory")
#define VM_WAIT() asm volatile("s_waitcnt vmcnt(0)" ::: "memory")
__device__ __forceinline__ unsigned long long rt() { return __builtin_amdgcn_s_memrealtime(); }
__device__ __forceinline__ unsigned f2bf(float f) { unsigned u = __builtin_bit_cast(unsigned, f); return (u + 0x7fffu + ((u >> 16) & 1u)) >> 16; }
__device__ __forceinline__ unsigned pk2(float lo, float hi) { return f2bf(lo) | (f2bf(hi) << 16); }

#define XB_TMO      128
#define XB_XCNT(j)  (256  + 64 * (j))
#define XB_XSUB(j)  (1280 + 64 * (j))
#define XB_XGEN(j)  (2304 + 64 * (j))
#define XB_TOP      3328
#define XB_TOPGEN   3392
#define XCD_BAR_WORDS 3456
#define XB_SPIN_CAP (1u << 18)

__device__ __forceinline__ unsigned xb_ld(unsigned* p)              { return __hip_atomic_load(p, __ATOMIC_RELAXED, __HIP_MEMORY_SCOPE_AGENT); }
__device__ __forceinline__ unsigned xb_add(unsigned* p, unsigned v) { return __hip_atomic_fetch_add(p, v, __ATOMIC_RELAXED, __HIP_MEMORY_SCOPE_AGENT); }
__device__ __forceinline__ unsigned xb_xcc_id() { return (unsigned)__builtin_amdgcn_s_getreg((3 << 11) | 20) & 0xFu; }
#define XB_SPIN(cond, bar) do { unsigned _sp = 0; while (cond) { __builtin_amdgcn_s_sleep(1); \
    if ((++_sp & 255u) == 0u) { if (xb_ld(&(bar)[XB_TMO])) break; if (_sp > XB_SPIN_CAP) { atomicAdd(&(bar)[XB_TMO], 1u); break; } } } } while (0)

struct XcdBarrier {
    unsigned* bar; unsigned x;
    volatile LAS unsigned* st;
};

__device__ __forceinline__ XcdBarrier xcd_barrier_post(unsigned* bar, volatile LAS unsigned* st) {
    XcdBarrier b; b.bar = bar; b.x = xb_xcc_id(); b.st = st;
    if (threadIdx.x == 0) (void)xb_add(&bar[XB_XCNT(b.x)], 1u);
    return b;
}
__device__ __forceinline__ void xcd_barrier_complete(unsigned* bar, unsigned x, unsigned& nloc, unsigned& nx) {
    const unsigned G = gridDim.x * gridDim.y * gridDim.z;
    unsigned sum, cnt, mine, sp = 0u;
    for (;;) {
        sum = 0u; cnt = 0u; mine = 0u;
#pragma unroll
        for (unsigned j = 0; j < 16; ++j) { const unsigned c = xb_ld(&bar[XB_XCNT(j)]); sum += c; cnt += (c > 0u) ? 1u : 0u; mine = (j == x) ? c : mine; }
        if (sum == G) break;
        __builtin_amdgcn_s_sleep(1);
        if ((++sp & 255u) == 0u) { if (xb_ld(&bar[XB_TMO])) break; if (sp > XB_SPIN_CAP) { atomicAdd(&bar[XB_TMO], 1u); break; } }
    }
    nloc = mine > 0u ? mine : 1u; nx = cnt > 0u ? cnt : 1u;
}

__device__ __forceinline__ void xcd_barrier(const XcdBarrier& b) {
    asm volatile("s_waitcnt vmcnt(0)" ::: "memory");
    __syncthreads();
    if (threadIdx.x == 0) {
        unsigned* bar = b.bar;
        __builtin_amdgcn_s_waitcnt(0);
        unsigned nloc = b.st[0], nx = b.st[1];
        if (nloc == 0u) { xcd_barrier_complete(bar, b.x, nloc, nx); b.st[0] = nloc; b.st[1] = nx; }
        const unsigned old = xb_add(&bar[XB_XSUB(b.x)], 1u);
        const unsigned gen = old / nloc;
        if (old + 1u == (gen + 1u) * nloc) {
            __builtin_amdgcn_fence(__ATOMIC_RELEASE, "agent");
            asm volatile("s_waitcnt vmcnt(0)" ::: "memory");
            const unsigned og = xb_add(&bar[XB_TOP], 1u);
            const unsigned tg = og / nx;
            if (og + 1u == (tg + 1u) * nx) xb_add(&bar[XB_TOPGEN], 1u);
            else XB_SPIN(xb_ld(&bar[XB_TOPGEN]) == tg, bar);
            __builtin_amdgcn_fence(__ATOMIC_ACQUIRE, "agent");
            xb_add(&bar[XB_XGEN(b.x)], 1u);
            asm volatile("s_waitcnt vmcnt(0)" ::: "memory");
        } else {
            XB_SPIN(xb_ld(&bar[XB_XGEN(b.x)]) == gen, bar);
            __builtin_amdgcn_fence(__ATOMIC_ACQUIRE, "agent");
            asm volatile("s_waitcnt vmcnt(0)" ::: "memory");
        }
    }
    __syncthreads();
}
struct Frame {
    LAS unsigned char* lds; volatile LAS unsigned* MISC;
    int tid, lane, wave, vcu, G;
    unsigned char* ws; float* out; const float* const* inp;
};
#define FIN(k) (F.inp[k])
#define F_x FIN(0)
#define F_mem FIN(1)
#define F_ln_g FIN(2)
#define F_w_in FIN(3)
#define F_gm_g FIN(4)
#define F_gm_b FIN(5)
#define F_gm_ws FIN(6)
#define F_gm_bs FIN(7)
#define F_conv_w FIN(8)
#define F_a_log FIN(9)
#define F_dt_bias FIN(10)
#define F_dn_g FIN(11)
#define F_mem_g FIN(12)
#define F_w_mem FIN(13)
#define F_w_out FIN(14)
#define F_final_g FIN(15)
#define F_ctl ((gu32*)(F.ws + WS_CTL))
#define F_XB ((bf16*)(F.ws + WS_XB))
#define F_WTIN ((bf16*)(F.ws + WS_WTIN))
#define F_WTOUT ((bf16*)(F.ws + WS_WTOUT))
#define F_MKV ((bf16*)(F.ws + WS_MKV))
#define F_P ((bf16*)(F.ws + WS_P))
#define F_MIXED ((bf16*)(F.ws + WS_MIXED))
#define F_APG ((bf16*)(F.ws + WS_APG))
#define F_BCT ((bf16*)(F.ws + WS_BCT))
#define F_SGRP ((bf16*)(F.ws + WS_SGRP))
#define F_GLXG ((float*)(F.ws + WS_GLXG))
#define F_AP ((bf16*)(F.ws + WS_AP))
#define F_BNT ((bf16*)(F.ws + WS_BNT))
#define F_QEFF ((bf16*)((unsigned char*)F.out + OUT_QEFF))
#define F_OIN ((bf16*)((unsigned char*)F.out + OUT_OIN))
#define F_RSTD ((float*)(F.ws + WS_RSTD))
#define F_AB ((float*)(F.ws + WS_AB))
#define F_GLX ((float*)(F.ws + WS_GLX))
#define DI __device__ __forceinline__
typedef unsigned u32x2 __attribute__((ext_vector_type(2)));
typedef float f32x2 __attribute__((ext_vector_type(2)));
typedef __bf16 bf16x2_t __attribute__((ext_vector_type(2)));
DI unsigned cvtpk(float lo, float hi) { const f32x2 f = {lo, hi}; const bf16x2_t v = __builtin_convertvector(f, bf16x2_t); return __builtin_bit_cast(unsigned, v); }
DI float bflo(unsigned w) { return __builtin_bit_cast(float, w << 16); }
DI float bfhi(unsigned w) { return __builtin_bit_cast(float, w & 0xffff0000u); }
DI float bf1(bf16 h) { return __builtin_bit_cast(float, (unsigned)h << 16); }
DI float fexp(float x) { return __builtin_amdgcn_exp2f(x * 1.44269504089f); }
DI float frcp(float x) { return __builtin_amdgcn_rcpf(x); }
DI float sigm(float x) { return frcp(1.f + fexp(-x)); }
DI float silu_f(float x) { return x * sigm(x); }
DI float gelu_f(float x) { const float y = 1.5957691216057308f * (x + 0.044715f * x * x * x); return x * sigm(y); }
DI float softplus_f(float x) { return fmaxf(x, 0.f) + __logf(1.f + fexp(-fabsf(x))); }
#define DPPF(v, ctrl) __builtin_bit_cast(float, __builtin_amdgcn_update_dpp(0, __builtin_bit_cast(int, (v)), (ctrl), 0xf, 0xf, true))
DI float wave_sum(float v) {
    v += DPPF(v, 0xB1); v += DPPF(v, 0x4E); v += DPPF(v, 0x141); v += DPPF(v, 0x140);
    const int vi = __builtin_bit_cast(int, v);
    return (__builtin_bit_cast(float, __builtin_amdgcn_readlane(vi, 0)) + __builtin_bit_cast(float, __builtin_amdgcn_readlane(vi, 16))) +
           (__builtin_bit_cast(float, __builtin_amdgcn_readlane(vi, 32)) + __builtin_bit_cast(float, __builtin_amdgcn_readlane(vi, 48)));
}
#define MFMA16(a, b, c) __builtin_amdgcn_mfma_f32_16x16x32_bf16((a), (b), (c), 0, 0, 0)
#define LDSW() asm volatile("s_waitcnt lgkmcnt(0)" ::: "memory")
DI void wg_sync() { __syncthreads(); }
DI f32x4 tile16(const LAS unsigned char* A, int lda, const LAS unsigned char* B, int ldb, int ksteps, f32x4 acc, int r, int q) {
    const LAS unsigned char* pa = A + r * lda + 16 * q; const LAS unsigned char* pb = B + r * ldb + 16 * q;
    for (int k = 0; k < ksteps; ++k) { const bf16x8 a = *(const LAS bf16x8*)(pa + 64 * k), b = *(const LAS bf16x8*)(pb + 64 * k); acc = MFMA16(a, b, acc); }
    return acc;
}

template <int MODE  >
DI void p0_transpose_item(const float* W, int srcN, int nblk, const float* g, bf16* WT, int row_off, LAS float* scr, int item, int lane) {
    const int kb = item / nblk, nb = item % nblk, k0 = 64 * kb, n0 = 64 * nb;
    const int nn = 4 * (lane & 15), np = n0 + nn;
    int sc = np; bool valid = true;
    if (MODE == 0) { sc = np < 5632 ? np : (np < 6656 ? np + 16 : 5632 + (np - 6656)); valid = np < NIN; }
    f32x4 v[16];
#pragma unroll
    for (int i = 0; i < 16; ++i) { const int kk = 4 * i + (lane >> 4); v[i] = (f32x4){0.f, 0.f, 0.f, 0.f}; if (valid) v[i] = *(const GAS f32x4*)(W + (size_t)(k0 + kk) * srcN + sc); }
#pragma unroll
    for (int i = 0; i < 16; ++i) { const int kk = 4 * i + (lane >> 4); f32x4 w = v[i]; if (MODE == 0) w = w * g[k0 + kk];
        LAS float* d = scr + kk * 65 + nn; d[0] = w.x; d[1] = w.y; d[2] = w.z; d[3] = w.w; }
    LDSW();
#pragma unroll
    for (int j = 0; j < 8; ++j) { const int p = lane + 64 * j, n = p >> 3, c = p & 7; const LAS float* s = scr + (8 * c) * 65 + n;
        v4u o; o.x = cvtpk(s[0 * 65], s[1 * 65]); o.y = cvtpk(s[2 * 65], s[3 * 65]); o.z = cvtpk(s[4 * 65], s[5 * 65]); o.w = cvtpk(s[6 * 65], s[7 * 65]);
        *(GAS v4u*)(WT + (size_t)(row_off + n0 + n) * DM + k0 + 8 * c) = o; }
    LDSW();
}
DI void p0_row(const float* xrow, bf16* orow, const float* g, float* rstd_out, int lane) {
    const GAS f32x4* xr = (const GAS f32x4*)xrow + lane;
    f32x4 v[8]; float s = 0.f;
#pragma unroll
    for (int j = 0; j < 8; ++j) { v[j] = xr[64 * j]; s += (v[j].x * v[j].x + v[j].y * v[j].y) + (v[j].z * v[j].z + v[j].w * v[j].w); }
    const float rs = 1.f / sqrtf(wave_sum(s) * (1.f / DM) + EPSF);
    if (rstd_out && lane == 0) *rstd_out = rs;
    GAS u32x2* o8 = (GAS u32x2*)orow + lane;
#pragma unroll
    for (int j = 0; j < 8; ++j) { f32x4 w = v[j]; if (g) { const f32x4 gg = ((const GAS f32x4*)g)[64 * j + lane]; w = w * rs * gg; }
        u32x2 o; o.x = cvtpk(w.x, w.y); o.y = cvtpk(w.z, w.w); o8[64 * j] = o; }
}
DI void p0_prologue(Frame& F) {
    LAS float* scr = (LAS float*)(F.lds + F.wave * 17408);
    const int gw = F.vcu * NWAVES + F.wave, NGW = F.G * NWAVES;
    constexpr int NB_IN = 105, I_IN = 32 * NB_IN, I_MEM = 32 * 16, I_OUT = 32 * 32, NITEMS = I_IN + I_MEM + I_OUT;
    for (int it = gw; it < NITEMS; it += NGW) {
        int r = it;
        if (r < I_IN) { p0_transpose_item<0>(F_w_in, NIN, NB_IN, F_ln_g, F_WTIN, 0, scr, r, F.lane); continue; } r -= I_IN;
        if (r < I_MEM) { p0_transpose_item<1>(F_w_mem, 1024, 16, nullptr, F_WTIN, NPADC, scr, r, F.lane); continue; } r -= I_MEM;
        p0_transpose_item<1>(F_w_out, 2048, 32, nullptr, F_WTOUT, 0, scr, r, F.lane);
    }
    { GAS v4u* z = (GAS v4u*)(F_WTIN + (size_t)6720 * DM); const int n16 = (NPADC - 6720) * DM * 2 / 16;
      for (int i = gw * 64 + F.lane; i < n16; i += NGW * 64) z[i] = (v4u){0u, 0u, 0u, 0u}; }
    for (int m = gw; m < SEQ + NMEMT; m += NGW) {
        if (m < SEQ) p0_row(F_x + (size_t)m * DM, F_XB + (size_t)m * DM, nullptr, F_RSTD + m, F.lane);
        else p0_row(F_mem + (size_t)(m - SEQ) * DM, F_XB + (size_t)m * DM, F_mem_g, nullptr, F.lane);
    }
}

DI void gmlp_item(Frame& F, int item) {
    int lane_ = F.lane, tid_ = F.tid; asm volatile("" : "+v"(lane_), "+v"(tid_));
    const int c = item >> 2, g = item & 3, t0 = 128 * c, lane = lane_, w = F.wave, r = lane & 15, q = lane >> 4;
    LAS unsigned char* Wb = F.lds; LAS unsigned char* VT = F.lds + 34816;
    { const float* Wg = F_gm_ws + (size_t)g * 16384;
#pragma unroll
      for (int i = 0; i < 8; ++i) { const int e = tid_ * 4 + i * 2048, row = e >> 7, col = e & 127; const f32x4 v = *(const GAS f32x4*)(Wg + e);
          u32x2 o; o.x = cvtpk(col <= row ? v.x : 0.f, col + 1 <= row ? v.y : 0.f); o.y = cvtpk(col + 2 <= row ? v.z : 0.f, col + 3 <= row ? v.w : 0.f);
          *(LAS u32x2*)(Wb + row * 272 + col * 2) = o; } }
    float gmg[8], gmb[8];
#pragma unroll
    for (int j = 0; j < 8; ++j) { gmg[j] = F_gm_g[128 * g + 8 * (lane & 15) + j]; gmb[j] = F_gm_b[128 * g + 8 * (lane & 15) + j]; }
#pragma unroll 1
    for (int i0 = 0; i0 < 16; i0 += 8) {
        v4u raw8[8];
#pragma unroll
        for (int ii = 0; ii < 8; ++ii) raw8[ii] = *(const GAS v4u*)(F_P + (size_t)(t0 + 16 * w + i0 + ii) * PLD + PC_GV + 8 * lane);
#pragma unroll
        for (int ii = 0; ii < 8; ++ii) { const int s = 16 * w + i0 + ii; const v4u raw = raw8[ii];
            float gv[8]; gv[0] = gelu_f(bflo(raw.x)); gv[1] = gelu_f(bfhi(raw.x)); gv[2] = gelu_f(bflo(raw.y)); gv[3] = gelu_f(bfhi(raw.y));
            gv[4] = gelu_f(bflo(raw.z)); gv[5] = gelu_f(bfhi(raw.z)); gv[6] = gelu_f(bflo(raw.w)); gv[7] = gelu_f(bfhi(raw.w));
            float sm = 0.f;
#pragma unroll
            for (int j = 0; j < 8; ++j) sm += gv[j];
            const float mean = wave_sum(sm) * (1.f / 512.f); float sq = 0.f;
#pragma unroll
            for (int j = 0; j < 8; ++j) { gv[j] -= mean; sq += gv[j] * gv[j]; }
            const float rs = 1.f / sqrtf(wave_sum(sq) * (1.f / 512.f) + EPSF);
            if ((lane >> 4) == g) {
#pragma unroll
                for (int j = 0; j < 8; ++j) { const int d = 8 * (lane & 15) + j; const float val = gv[j] * rs * gmg[j] + gmb[j];
                    *(LAS unsigned short*)(VT + d * 272 + s * 2) = (unsigned short)cvtpk(val, 0.f); } }
        }
    }
    LDSW(); wg_sync();
    f32x4 acc[8]; const int ks = (w >> 1) + 1;
#pragma unroll
    for (int dt = 0; dt < 8; ++dt) { acc[dt] = (f32x4){0.f, 0.f, 0.f, 0.f}; acc[dt] = tile16(VT + 16 * dt * 272, 272, Wb + 16 * w * 272, 272, ks, acc[dt], r, q); }
    { const int tl = 16 * w + r, t = t0 + tl; const float bsv = F_gm_bs[g * 128 + tl];
      const bf16* prow = F_P + (size_t)t * PLD + 128 * g + 4 * q; bf16* orow = F_MIXED + (size_t)t * DM + MC_A + 128 * g + 4 * q;
#pragma unroll
      for (int dt = 0; dt < 8; ++dt) { const u32x2 u = *(const GAS u32x2*)(prow + PC_GU + 16 * dt), z = *(const GAS u32x2*)(prow + PC_GZ + 16 * dt);
          const float o0 = gelu_f(bflo(u.x)) * (acc[dt][0] + bsv) * silu_f(bflo(z.x)), o1 = gelu_f(bfhi(u.x)) * (acc[dt][1] + bsv) * silu_f(bfhi(z.x));
          const float o2 = gelu_f(bflo(u.y)) * (acc[dt][2] + bsv) * silu_f(bflo(z.y)), o3 = gelu_f(bfhi(u.y)) * (acc[dt][3] + bsv) * silu_f(bfhi(z.y));
          u32x2 o; o.x = cvtpk(o0, o1); o.y = cvtpk(o2, o3); *(GAS u32x2*)(orow + 16 * dt) = o; } }
    wg_sync();
}

DI void xattn_item(Frame& F, int item) {
    int lane_ = F.lane, tid_ = F.tid; asm volatile("" : "+v"(lane_), "+v"(tid_));
    const int h = item & 3, qb = item >> 2, t0 = 128 * qb, lane = lane_, w = F.wave, r = lane & 15, q = lane >> 4;
    LAS unsigned char* KL = F.lds; LAS unsigned char* VL = F.lds + 69632;
    { const bf16* mk = F_MKV + 128 * h; const bf16* mv = F_MKV + 512 + 128 * h;
#pragma unroll
      for (int i = 0; i < 8; ++i) { const int c = tid_ + 512 * i, key = c >> 4, ch = c & 15;
          *(LAS v4u*)(KL + key * 272 + ch * 16) = *(const GAS v4u*)(mk + (size_t)key * 1024 + ch * 8);
          const v4u vv = *(const GAS v4u*)(mv + (size_t)key * 1024 + ch * 8); LAS unsigned char* vp = VL + (ch * 8) * 528 + key * 2;
          *(LAS unsigned short*)(vp) = (unsigned short)vv.x; *(LAS unsigned short*)(vp + 528) = (unsigned short)(vv.x >> 16);
          *(LAS unsigned short*)(vp + 2 * 528) = (unsigned short)vv.y; *(LAS unsigned short*)(vp + 3 * 528) = (unsigned short)(vv.y >> 16);
          *(LAS unsigned short*)(vp + 4 * 528) = (unsigned short)vv.z; *(LAS unsigned short*)(vp + 5 * 528) = (unsigned short)(vv.z >> 16);
          *(LAS unsigned short*)(vp + 6 * 528) = (unsigned short)vv.w; *(LAS unsigned short*)(vp + 7 * 528) = (unsigned short)(vv.w >> 16); } }
    const int t = t0 + 16 * w + r;
    bf16x8 bq[4];
#pragma unroll
    for (int ks = 0; ks < 4; ++ks) bq[ks] = *(const GAS bf16x8*)(F_P + (size_t)t * PLD + PC_CQ + 128 * h + 32 * ks + 8 * q);
    LDSW(); wg_sync();
    f32x4 s[16];
#pragma unroll
    for (int kt = 0; kt < 16; ++kt) { s[kt] = (f32x4){0.f, 0.f, 0.f, 0.f};
#pragma unroll
        for (int ks = 0; ks < 4; ++ks) { const bf16x8 a = *(const LAS bf16x8*)(KL + (16 * kt + r) * 272 + 64 * ks + 16 * q); s[kt] = MFMA16(a, bq[ks], s[kt]); }
        if (kt & 1) __builtin_amdgcn_sched_barrier(0); }
    float mx = -3.0e38f;
#pragma unroll
    for (int kt = 0; kt < 16; ++kt) mx = fmaxf(fmaxf(fmaxf(s[kt][0], s[kt][1]), fmaxf(s[kt][2], s[kt][3])), mx);
    mx = fmaxf(mx, __shfl_xor(mx, 16)); mx = fmaxf(mx, __shfl_xor(mx, 32));
    const float sc = 0.08838834764831845f * 1.44269504089f; float l = 0.f;
#pragma unroll
    for (int kt = 0; kt < 16; ++kt)
#pragma unroll
        for (int j = 0; j < 4; ++j) { const float p = __builtin_amdgcn_exp2f((s[kt][j] - mx) * sc); s[kt][j] = p; l += p; }
    l += __shfl_xor(l, 16); l += __shfl_xor(l, 32);
    f32x4 o[8];
#pragma unroll
    for (int dt = 0; dt < 8; ++dt) o[dt] = (f32x4){0.f, 0.f, 0.f, 0.f};
#pragma unroll
    for (int kk = 0; kk < 8; ++kk) {
        v4u pw; pw.x = cvtpk(s[2 * kk][0], s[2 * kk][1]); pw.y = cvtpk(s[2 * kk][2], s[2 * kk][3]); pw.z = cvtpk(s[2 * kk + 1][0], s[2 * kk + 1][1]); pw.w = cvtpk(s[2 * kk + 1][2], s[2 * kk + 1][3]);
        const bf16x8 bp = __builtin_bit_cast(bf16x8, pw);
#pragma unroll
        for (int dt = 0; dt < 8; ++dt) { const LAS unsigned char* vp = VL + (16 * dt + r) * 528 + 64 * kk + 8 * q;
            const u32x2 lo = *(const LAS u32x2*)vp, hi = *(const LAS u32x2*)(vp + 32);
            v4u av; av.x = lo.x; av.y = lo.y; av.z = hi.x; av.w = hi.y;
            o[dt] = MFMA16(__builtin_bit_cast(bf16x8, av), bp, o[dt]); }
        __builtin_amdgcn_sched_barrier(0); }
    { const float inv = 1.f / l; const bf16* zrow = F_P + (size_t)t * PLD + PC_CZ + 128 * h + 4 * q; bf16* orow = F_MIXED + (size_t)t * DM + MC_C + 128 * h + 4 * q;
#pragma unroll
      for (int dt = 0; dt < 8; ++dt) { const u32x2 z = *(const GAS u32x2*)(zrow + 16 * dt);
          u32x2 ov; ov.x = cvtpk(o[dt][0] * inv * silu_f(bflo(z.x)), o[dt][1] * inv * silu_f(bfhi(z.x))); ov.y = cvtpk(o[dt][2] * inv * silu_f(bflo(z.y)), o[dt][3] * inv * silu_f(bfhi(z.y)));
          *(GAS u32x2*)(orow + 16 * dt) = ov; } }
    wg_sync();
}
constexpr int L_KB = 0, L_QB = 17408, L_KT = 34816, L_VT = 52224, L_GT = 70656, L_DT = 89088, L_AF = 107520, L_TB = 124928, L_AI = 134144, L_SM = 143360, L_SS = 145408;
DI void dnprep_item(Frame& F, int item, f32x4 (&X)[16], float& sigma, int j) {
    int lane_ = F.lane, tid_ = F.tid; asm volatile("" : "+v"(lane_), "+v"(tid_));
    const int h = item >> 7, n = item & 127, t0 = 64 * n, lane = lane_, w = F.wave, tid = tid_, r = lane & 15, q = lane >> 4;
    LAS unsigned char* L = F.lds;
    LAS float* gcs = (LAS float*)(L + L_SM); LAS float* bts = gcs + 64; LAS float* ssq = gcs + 128;
    LAS float* TF = (LAS float*)(L + L_KT); LAS float* AF = (LAS float*)(L + L_AF); LAS float* SS = (LAS float*)(L + L_SS);
    if (w == 0) {
#if defined(DBG_AB)
        float a = 0.f, b = 0.f;
        { const float* xr = F_x + (size_t)(t0 + lane) * DM; const float* wi = F_w_in; const float* lg = F_ln_g; float ssx = 0.f;
          for (int k = 0; k < DM; ++k) { const float xv_ = xr[k]; ssx += xv_ * xv_; const float hk = xv_ * lg[k]; a += hk * wi[(size_t)k * NIN + 5632 + h]; b += hk * wi[(size_t)k * NIN + 5640 + h]; }
          const float rs_ = 1.f / sqrtf(ssx * (1.f / DM) + EPSF); a *= rs_; b *= rs_; }
#else
        const float a = F_AB[(size_t)(t0 + lane) * 16 + h], b = F_AB[(size_t)(t0 + lane) * 16 + 8 + h];
#endif
        float g = -__expf(F_a_log[h]) * softplus_f(a + F_dt_bias[h]);
#pragma unroll
        for (int o = 1; o < 64; o <<= 1) { const float u = __shfl_up(g, o); if (lane >= o) g += u; }
        gcs[lane] = g; bts[lane] = sigm(b);
        if (lane == 63) F_GLX[item] = __expf(g);
    }
    for (int i = tid; i < 9216 / 4; i += 512) ((LAS unsigned*)(L + L_TB))[i] = 0u;
    const int d = tid & 127, oct = tid >> 7;
    LDSW(); wg_sync();
    const float gl = gcs[63];
#pragma unroll 1
    for (int p = 0; p < 2; ++p) { const int tb = 8 * (oct + 4 * p);
        float yq[8], yk[8];
#pragma unroll
        for (int sgi = 0; sgi < 3; ++sgi) { const int col = (sgi == 0 ? PC_DQ : (sgi == 1 ? PC_DK : PC_DV)) + 128 * h + d; const int cw = sgi * 1024 + 128 * h + d;
            const float w0 = F_conv_w[cw], w1 = F_conv_w[3072 + cw], w2 = F_conv_w[6144 + cw], w3 = F_conv_w[9216 + cw];
            float xv[11];
#pragma unroll
            for (int j = 0; j < 11; ++j) { const int tt = t0 + tb - 3 + j, tc = tt < 0 ? 0 : tt; const float xl = bf1(F_P[(size_t)tc * PLD + col]); xv[j] = tt < 0 ? 0.f : xl; }
            float y[8];
#pragma unroll
            for (int i = 0; i < 8; ++i) y[i] = silu_f(w0 * xv[i] + w1 * xv[i + 1] + w2 * xv[i + 2] + w3 * xv[i + 3]);
            if (sgi == 0) {
#pragma unroll
                for (int i = 0; i < 8; ++i) yq[i] = y[i];
            } else if (sgi == 1) {
#pragma unroll
                for (int i = 0; i < 8; ++i) yk[i] = y[i];
            } else {
#pragma unroll
                for (int i = 0; i < 8; ++i) y[i] *= bts[tb + i];
                v4u o; o.x = cvtpk(y[0], y[1]); o.y = cvtpk(y[2], y[3]); o.z = cvtpk(y[4], y[5]); o.w = cvtpk(y[6], y[7]); *(LAS v4u*)(L + L_VT + d * 144 + tb * 2) = o;
            }
            asm volatile("" ::: "memory");
        }
#pragma unroll
        for (int i = 0; i < 8; ++i) { const float sq_ = wave_sum(yq[i] * yq[i]), sk_ = wave_sum(yk[i] * yk[i]);
            if (lane == 0) { ssq[((w & 1) * 2 + 0) * 64 + tb + i] = sq_; ssq[((w & 1) * 2 + 1) * 64 + tb + i] = sk_; } }
        LDSW(); wg_sync();
        float kg[8], kd[8];
#pragma unroll
        for (int i = 0; i < 8; ++i) { const int t = tb + i;
            const float rnq = 0.08838834764831845f / sqrtf(ssq[t] + ssq[128 + t] + EPSF), rnk = 1.f / sqrtf(ssq[64 + t] + ssq[192 + t] + EPSF);
            const float bt = bts[t], gc = gcs[t], kk = yk[i] * rnk;
            *(LAS unsigned short*)(L + L_QB + t * 272 + d * 2) = (unsigned short)cvtpk(yq[i] * rnq, 0.f);
            *(LAS unsigned short*)(L + L_KB + t * 272 + d * 2) = (unsigned short)cvtpk(kk, 0.f);
            *(LAS unsigned short*)(L + L_KT + t * 272 + d * 2) = (unsigned short)cvtpk(kk * bt, 0.f);
            kg[i] = kk * bt * __expf(gc); kd[i] = kk * __expf(gl - gc); }
        v4u o; o.x = cvtpk(kg[0], kg[1]); o.y = cvtpk(kg[2], kg[3]); o.z = cvtpk(kg[4], kg[5]); o.w = cvtpk(kg[6], kg[7]); *(LAS v4u*)(L + L_GT + d * 144 + tb * 2) = o;
        o.x = cvtpk(kd[0], kd[1]); o.y = cvtpk(kd[2], kd[3]); o.z = cvtpk(kd[4], kd[5]); o.w = cvtpk(kd[6], kd[7]); *(LAS v4u*)(L + L_DT + d * 144 + tb * 2) = o;
    }
    LDSW(); wg_sync();
    { const int which = w >> 2, it = w & 3; const int i = 16 * it + r; const float gi = gcs[i];
      for (int jt = 0; jt < 4; ++jt) { f32x4 acc = (f32x4){0.f, 0.f, 0.f, 0.f};
          if (jt <= it) acc = tile16(L + L_KB + 16 * jt * 272, 272, L + (which ? L_QB : L_KT) + 16 * it * 272, 272, 4, acc, r, q);
          float v[4];
#pragma unroll
          for (int j = 0; j < 4; ++j) { const int jc = 16 * jt + 4 * q + j; const bool keep = which ? (i >= jc) : (i > jc); v[j] = keep ? acc[j] * __expf(gi - gcs[jc]) : 0.f; }
          if (which) { u32x2 o; o.x = cvtpk(v[0], v[1]); o.y = cvtpk(v[2], v[3]); *(LAS u32x2*)(L + L_AI + i * 144 + (16 * jt + 4 * q) * 2) = o; }
          else *(LAS f32x4*)(AF + i * 68 + 16 * jt + 4 * q) = (f32x4){v[0], v[1], v[2], v[3]}; } }
    LDSW(); wg_sync();
    if (w == 0) { const int b = lane >> 4, c = lane & 15; float tt[16];
#pragma unroll
        for (int i = 0; i < 16; ++i) { float v = (i == c) ? 1.f : 0.f;
#pragma unroll
            for (int j = 0; j < i; ++j) v -= AF[(16 * b + i) * 68 + 16 * b + j] * tt[j];
            tt[i] = v; TF[(16 * b + i) * 68 + 16 * b + c] = v; asm volatile("" ::: "memory"); } }
    LDSW(); wg_sync();
    for (int Lv = 1; Lv < 4; ++Lv) { const int np_ = 4 - Lv;
        for (int o = tid; o < np_ * 256; o += 512) { const int p = o >> 8, rr = (o >> 4) & 15, cc = o & 15, bj = p, bi = p + Lv; float s = 0.f;
            for (int m = 16 * bj; m < 16 * bi; ++m) s += AF[(16 * bi + rr) * 68 + m] * TF[m * 68 + 16 * bj + cc];
            SS[o] = s; }
        LDSW(); wg_sync();
        for (int o = tid; o < np_ * 256; o += 512) { const int p = o >> 8, rr = (o >> 4) & 15, cc = o & 15, bj = p, bi = p + Lv; float s = 0.f;
#pragma unroll
            for (int m = 0; m < 16; ++m) s += TF[(16 * bi + rr) * 68 + 16 * bi + m] * SS[p * 256 + m * 16 + cc];
            TF[(16 * bi + rr) * 68 + 16 * bj + cc] = -s; }
        LDSW(); wg_sync(); }
    for (int o = tid; o < 2048; o += 512) { const int i = o >> 5, j2 = (o & 31) * 2; if ((j2 >> 4) <= (i >> 4)) *(LAS unsigned*)(L + L_TB + i * 144 + j2 * 2) = cvtpk(TF[i * 68 + j2], TF[i * 68 + j2 + 1]); }
    LDSW(); wg_sync();
    { const int which = w >> 2, it = w & 3; f32x4 acc[8];
#pragma unroll
      for (int dt = 0; dt < 8; ++dt) { acc[dt] = (f32x4){0.f, 0.f, 0.f, 0.f}; acc[dt] = tile16(L + L_TB + 16 * it * 144, 144, L + (which ? L_GT : L_VT) + 16 * dt * 144, 144, 2, acc[dt], r, q); }
      LDSW(); wg_sync();
#pragma unroll
      for (int dt = 0; dt < 8; ++dt) { u32x2 o; o.x = cvtpk(acc[dt][0], acc[dt][1]); o.y = cvtpk(acc[dt][2], acc[dt][3]);
#if defined(DBG_O) && DBG_O == 1
          if (which)
#endif
          *(LAS u32x2*)(L + (which ? L_GT : L_VT) + (16 * dt + r) * 144 + (16 * it + 4 * q) * 2) = o; } }
    LDSW(); wg_sync();
    { bf16* Ap = F_AP + (size_t)item * 16384; bf16* BnT = F_BNT + (size_t)item * 16384; bf16* Qe = F_QEFF + (size_t)item * 8192; bf16* Oi = F_OIN + (size_t)item * 8192;
#pragma unroll
      for (int d2t = 0; d2t < 8; ++d2t) { f32x4 acc = (f32x4){0.f, 0.f, 0.f, 0.f}; acc = tile16(L + L_GT + 16 * d2t * 144, 144, L + L_DT + 16 * w * 144, 144, 2, acc, r, q);
          u32x2 o; o.x = cvtpk(-acc[0], -acc[1]); o.y = cvtpk(-acc[2], -acc[3]);
          *(GAS u32x2*)(Ap + (((w * 4 + (d2t >> 1)) * 64 + ((d2t & 1) * 2 + (q >> 1)) * 16 + r) * 8 + 4 * (q & 1))) = o; }
#pragma unroll
      for (int d1t = 0; d1t < 8; ++d1t) { f32x4 acc = (f32x4){0.f, 0.f, 0.f, 0.f}; acc = tile16(L + L_DT + 16 * d1t * 144, 144, L + L_VT + 16 * w * 144, 144, 2, acc, r, q);
          u32x2 o; o.x = cvtpk(acc[0], acc[1]); o.y = cvtpk(acc[2], acc[3]); *(GAS u32x2*)(BnT + (16 * w + r) * 128 + 16 * d1t + 4 * q) = o; }
      { const int it = w & 3, dh = w >> 2, i = 16 * it + r; const float eg = __expf(gcs[i]);
#pragma unroll
        for (int dd = 0; dd < 4; ++dd) { const int dt = 4 * dh + dd, dc = 16 * dt + 4 * q;
            f32x4 a1 = (f32x4){0.f, 0.f, 0.f, 0.f}, a2 = a1;
            a1 = tile16(L + L_GT + 16 * dt * 144, 144, L + L_AI + 16 * it * 144, 144, 2, a1, r, q);
            a2 = tile16(L + L_VT + 16 * dt * 144, 144, L + L_AI + 16 * it * 144, 144, 2, a2, r, q);
            const u32x2 qv = *(const LAS u32x2*)(L + L_QB + i * 272 + dc * 2);
            u32x2 o; o.x = cvtpk(bflo(qv.x) * eg - a1[0], bfhi(qv.x) * eg - a1[1]); o.y = cvtpk(bflo(qv.y) * eg - a1[2], bfhi(qv.y) * eg - a1[3]);
            *(GAS u32x2*)(Qe + i * 128 + dc) = o;
#if defined(DBG_O)
            { float vv[4];
#pragma unroll
              for (int j = 0; j < 4; ++j) vv[j] = bf1(*(const LAS unsigned short*)(L + L_VT + (dc + j) * 144 + i * 2));
              a2 = (f32x4){vv[0], vv[1], vv[2], vv[3]}; }
#endif
            o.x = cvtpk(a2[0], a2[1]); o.y = cvtpk(a2[2], a2[3]); *(GAS u32x2*)(Oi + i * 128 + dc) = o; } } }
    wg_sync();
    { constexpr int L_XM = 0, L_XB = 107520;
      const float egc = __expf(gcs[63]);
      if (j > 0) {
#pragma unroll
          for (int et = 0; et < 16; ++et) { u32x2 o; o.x = cvtpk(X[et][0], X[et][1]); o.y = cvtpk(X[et][2], X[et][3]);
              *(LAS u32x2*)(L + (et < 8 ? L_XM : L_XB) + (16 * (et & 7) + r) * 272 + (16 * w + 4 * q) * 2) = o; }
          LDSW(); wg_sync();
          bf16x8 af[4];
#pragma unroll
          for (int ks = 0; ks < 4; ++ks) { f32x4 ta = (f32x4){0.f, 0.f, 0.f, 0.f}, tb = ta;
              ta = tile16(L + L_GT + 16 * (2 * ks) * 144, 144, L + L_DT + 16 * w * 144, 144, 2, ta, r, q); tb = tile16(L + L_GT + 16 * (2 * ks + 1) * 144, 144, L + L_DT + 16 * w * 144, 144, 2, tb, r, q);
              v4u pw; pw.x = cvtpk(-ta[0], -ta[1]); pw.y = cvtpk(-ta[2], -ta[3]); pw.z = cvtpk(-tb[0], -tb[1]); pw.w = cvtpk(-tb[2], -tb[3]); af[ks] = __builtin_bit_cast(bf16x8, pw); }
#pragma unroll
          for (int et = 0; et < 16; ++et) { f32x4 add = (f32x4){0.f, 0.f, 0.f, 0.f};
              if (et < 8) { add = tile16(L + L_DT + 16 * w * 144, 144, L + L_GT + 16 * et * 144, 144, 2, add, r, q); add = add * (-sigma); }
              else add = tile16(L + L_DT + 16 * w * 144, 144, L + L_VT + 16 * (et - 8) * 144, 144, 2, add, r, q);
              f32x4 c = X[et] * egc + add;
              const LAS unsigned char* xp = L + (et < 8 ? L_XM : L_XB) + (16 * (et & 7) + r) * 272 + 8 * q;
#pragma unroll
              for (int ks = 0; ks < 4; ++ks) { const u32x2 lo = *(const LAS u32x2*)(xp + 64 * ks), hi = *(const LAS u32x2*)(xp + 64 * ks + 32);
                  v4u bv; bv.x = lo.x; bv.y = lo.y; bv.z = hi.x; bv.w = hi.y; c = MFMA16(af[ks], __builtin_bit_cast(bf16x8, bv), c); }
              X[et] = c; }
          sigma *= egc;
      } else {
#pragma unroll
          for (int et = 0; et < 16; ++et) { f32x4 add = (f32x4){0.f, 0.f, 0.f, 0.f};
              if (et < 8) { add = tile16(L + L_DT + 16 * w * 144, 144, L + L_GT + 16 * et * 144, 144, 2, add, r, q); add = -add; }
              else add = tile16(L + L_DT + 16 * w * 144, 144, L + L_VT + 16 * (et - 8) * 144, 144, 2, add, r, q);
              X[et] = add; }
          sigma = egc;
      }
    }
    LDSW(); wg_sync();
}
DI void dngroup_finish(Frame& F, int grp, const f32x4 (&X)[16], float sigma) {
    const int lane = F.lane, w = F.wave, r = lane & 15, q = lane >> 4; LAS unsigned char* L = F.lds;
    bf16* Bc = F_BCT + (size_t)grp * 16384;
#pragma unroll
    for (int et = 0; et < 8; ++et) { u32x2 o; o.x = cvtpk(X[8 + et][0], X[8 + et][1]); o.y = cvtpk(X[8 + et][2], X[8 + et][3]); *(GAS u32x2*)(Bc + (16 * et + r) * 128 + 16 * w + 4 * q) = o;
        o.x = cvtpk(X[et][0], X[et][1]); o.y = cvtpk(X[et][2], X[et][3]); *(LAS u32x2*)(L + (16 * et + r) * 272 + (16 * w + 4 * q) * 2) = o; }
    LDSW(); wg_sync();
    bf16* Ag = F_APG + (size_t)grp * 16384;
#pragma unroll
    for (int ks = 0; ks < 4; ++ks) { unsigned short e[8];
#pragma unroll
        for (int jj = 0; jj < 8; ++jj) e[jj] = *(const LAS unsigned short*)(L + (32 * ks + 8 * q + jj) * 272 + (16 * w + r) * 2);
        v4u o; o.x = e[0] | ((unsigned)e[1] << 16); o.y = e[2] | ((unsigned)e[3] << 16); o.z = e[4] | ((unsigned)e[5] << 16); o.w = e[6] | ((unsigned)e[7] << 16);
        *(GAS v4u*)(Ag + ((w * 4 + ks) * 64 + lane) * 8) = o; }
    if (F.tid == 0) F_GLXG[grp] = sigma;
    LDSW(); wg_sync();
}

struct ScanSet { bf16x8 af[4]; u32x2 bn[2]; float eg; };
DI void scan_load(Frame& F, ScanSet& s, int item, int w, int e0, int lane, int r, int q, int zlane) {
    const bf16* Ap = F_APG + (size_t)item * 16384 + (size_t)(w * 4) * 512 + lane * 8;
#pragma unroll
    for (int ks = 0; ks < 4; ++ks) s.af[ks] = *(const GAS bf16x8*)(Ap + ks * 512);
    const bf16* BnT = F_BCT + (size_t)item * 16384 + (size_t)(e0 + r) * 128 + 16 * w + 4 * q;
    s.bn[0] = *(const GAS u32x2*)BnT; s.bn[1] = *(const GAS u32x2*)(BnT + 16 * 128);
    s.eg = F_GLXG[item + zlane];
}
DI void scan_step(Frame& F, const ScanSet& s, f32x4 (&acc)[2], int item, int buf, int w, int e0, int r, int q) {
    LAS unsigned char* ST = F.lds + buf * 8704;
    bf16* Sg = F_SGRP + (size_t)item * 16384 + (size_t)(e0 + r) * 128 + 16 * w + 4 * q;
#pragma unroll
    for (int et = 0; et < 2; ++et) { u32x2 o; o.x = cvtpk(acc[et][0], acc[et][1]); o.y = cvtpk(acc[et][2], acc[et][3]);
        *(LAS u32x2*)(ST + (16 * et + r) * 272 + (16 * w + 4 * q) * 2) = o; *(GAS u32x2*)(Sg + et * 16 * 128) = o; }
    LDSW(); __builtin_amdgcn_s_barrier(); asm volatile("" ::: "memory");
    bf16x8 bfr[2][4];
#pragma unroll
    for (int et = 0; et < 2; ++et)
#pragma unroll
        for (int ks = 0; ks < 4; ++ks) bfr[et][ks] = *(const LAS bf16x8*)(ST + (16 * et + r) * 272 + 64 * ks + 16 * q);
#pragma unroll
    for (int et = 0; et < 2; ++et) { f32x4 c;
        c[0] = acc[et][0] * s.eg + bflo(s.bn[et].x); c[1] = acc[et][1] * s.eg + bfhi(s.bn[et].x); c[2] = acc[et][2] * s.eg + bflo(s.bn[et].y); c[3] = acc[et][3] * s.eg + bfhi(s.bn[et].y);
#pragma unroll
        for (int ks = 0; ks < 4; ++ks) c = MFMA16(s.af[ks], bfr[et][ks], c);
        acc[et] = c; }
}
DI void scan_slice(Frame& F, int h, int slice) {
    const int lane = F.lane, w = F.wave, r = lane & 15, q = lane >> 4, e0 = 32 * slice, i0 = h * 32;
    f32x4 acc[2] = {(f32x4){0.f, 0.f, 0.f, 0.f}, (f32x4){0.f, 0.f, 0.f, 0.f}};
    ScanSet s0, s1, s2, s3;
    int zlane = 0; asm volatile("" : "+v"(zlane));
    scan_load(F, s0, i0, w, e0, lane, r, q, zlane); scan_load(F, s1, i0 + 1, w, e0, lane, r, q, zlane); scan_load(F, s2, i0 + 2, w, e0, lane, r, q, zlane);
    for (int n = 0; n < 32; n += 4) {
        scan_load(F, s3, i0 + n + 3, w, e0, lane, r, q, zlane);
        scan_step(F, s0, acc, i0 + n, 0, w, e0, r, q);
        if (n + 4 < 32) scan_load(F, s0, i0 + n + 4, w, e0, lane, r, q, zlane);
        scan_step(F, s1, acc, i0 + n + 1, 1, w, e0, r, q);
        if (n + 4 < 32) scan_load(F, s1, i0 + n + 5, w, e0, lane, r, q, zlane);
        scan_step(F, s2, acc, i0 + n + 2, 0, w, e0, r, q);
        if (n + 4 < 32) scan_load(F, s2, i0 + n + 6, w, e0, lane, r, q, zlane);
        scan_step(F, s3, acc, i0 + n + 3, 1, w, e0, r, q);
    }
    LDSW(); wg_sync();
}

struct OSet { v4u ar[4]; v4u qr[2]; u32x2 oi[4]; u32x2 bn[8]; u32x2 z[4]; float eg; };
DI void oset_load(Frame& F, OSet& s, int h, int g, int j, int tid, int w, int r, int q, int zlane) {
    const int item = h * 128 + 4 * g + j, t0 = 64 * (4 * g + j);
    if (j < 3) { const bf16* Ap = F_AP + (size_t)item * 16384;
#pragma unroll
        for (int i = 0; i < 4; ++i) s.ar[i] = *(const GAS v4u*)(Ap + (size_t)(tid + 512 * i) * 8);
        const bf16* BnT = F_BNT + (size_t)item * 16384 + (16 * w + r) * 128 + 4 * q;
#pragma unroll
        for (int dt = 0; dt < 8; ++dt) s.bn[dt] = *(const GAS u32x2*)(BnT + 16 * dt);
        s.eg = F_GLX[item + zlane]; }
    { const bf16* Qe = F_QEFF + (size_t)item * 8192;
#pragma unroll
      for (int i = 0; i < 2; ++i) s.qr[i] = *(const GAS v4u*)(Qe + (size_t)(tid + 512 * i) * 8); }
    const bf16* Oi = F_OIN + (size_t)item * 8192 + r * 128 + 16 * w + 4 * q;
#pragma unroll
    for (int it = 0; it < 4; ++it) { s.oi[it] = *(const GAS u32x2*)(Oi + it * 2048);
        s.z[it] = *(const GAS u32x2*)(F_P + (size_t)(t0 + 16 * it + r) * PLD + PC_DZ + 128 * h + 16 * w + 4 * q); }
}
DI void oset_process(Frame& F, const OSet& s, f32x4 (&acc)[8], int h, int g, int j, int tid, int lane, int w, int r, int q) {
    const int t0 = 64 * (4 * g + j);
    LAS unsigned char* L = F.lds; LAS unsigned char* AL = L + (j & 1) * 32768; LAS unsigned char* QL = L + 65536 + (j & 1) * 17408;
    LAS unsigned char* ST = L + 100352 + w * 4352; LAS float* RED = (LAS float*)(L + 135168);
#pragma unroll
    for (int dt = 0; dt < 8; ++dt) { u32x2 o; o.x = cvtpk(acc[dt][0], acc[dt][1]); o.y = cvtpk(acc[dt][2], acc[dt][3]); *(LAS u32x2*)(ST + r * 272 + (16 * dt + 4 * q) * 2) = o; }
    if (j < 3) {
#pragma unroll
        for (int i = 0; i < 4; ++i) *(LAS v4u*)(AL + (tid + 512 * i) * 16) = s.ar[i]; }
#pragma unroll
    for (int i = 0; i < 2; ++i) { const int c = tid + 512 * i; *(LAS v4u*)(QL + (c >> 4) * 272 + (c & 15) * 16) = s.qr[i]; }
    LDSW(); wg_sync();
    bf16x8 sf[4];
#pragma unroll
    for (int ks = 0; ks < 4; ++ks) sf[ks] = *(const LAS bf16x8*)(ST + r * 272 + 64 * ks + 16 * q);
    f32x4 o[4];
#pragma unroll
    for (int it = 0; it < 4; ++it) { f32x4 c = (f32x4){bflo(s.oi[it].x), bfhi(s.oi[it].x), bflo(s.oi[it].y), bfhi(s.oi[it].y)};
#pragma unroll
        for (int ks = 0; ks < 4; ++ks) { const bf16x8 bq = *(const LAS bf16x8*)(QL + (16 * it + r) * 272 + 64 * ks + 16 * q); c = MFMA16(sf[ks], bq, c); }
        o[it] = c; float ss = (c[0] * c[0] + c[1] * c[1]) + (c[2] * c[2] + c[3] * c[3]); ss += __shfl_xor(ss, 16); ss += __shfl_xor(ss, 32);
        if (q == 0) RED[(16 * it + r) * 8 + w] = ss; }
    LDSW(); wg_sync();
    { const f32x4 gg = *(const GAS f32x4*)(F_dn_g + 16 * w + 4 * q);
#pragma unroll
      for (int it = 0; it < 4; ++it) { const f32x4 p0 = *(const LAS f32x4*)(RED + (16 * it + r) * 8), p1 = *(const LAS f32x4*)(RED + (16 * it + r) * 8 + 4);
          const float tot = ((p0[0] + p0[1]) + (p0[2] + p0[3])) + ((p1[0] + p1[1]) + (p1[2] + p1[3])); const float rs = 1.f / sqrtf(tot * (1.f / 128.f) + EPSF);
          const int t = t0 + 16 * it + r; const u32x2 z = s.z[it];
          u32x2 ov; ov.x = cvtpk(o[it][0] * rs * gg[0] * silu_f(bflo(z.x)), o[it][1] * rs * gg[1] * silu_f(bfhi(z.x))); ov.y = cvtpk(o[it][2] * rs * gg[2] * silu_f(bflo(z.y)), o[it][3] * rs * gg[3] * silu_f(bfhi(z.y)));
          *(GAS u32x2*)(F_MIXED + (size_t)t * DM + MC_B + 128 * h + 16 * w + 4 * q) = ov; } }
    if (j < 3) {
#pragma unroll
        for (int dt = 0; dt < 8; ++dt) { const u32x2 bn = s.bn[dt]; f32x4 c;
            c[0] = acc[dt][0] * s.eg + bflo(bn.x); c[1] = acc[dt][1] * s.eg + bfhi(bn.x); c[2] = acc[dt][2] * s.eg + bflo(bn.y); c[3] = acc[dt][3] * s.eg + bfhi(bn.y);
#pragma unroll
            for (int ks = 0; ks < 4; ++ks) { const bf16x8 a = *(const LAS bf16x8*)(AL + ((dt * 4 + ks) * 64 + lane) * 16); c = MFMA16(a, sf[ks], c); }
            acc[dt] = c; } }
}
DI void dnout_group(Frame& F, int grp) {
    int lane_ = F.lane, tid_ = F.tid, zlane = 0; asm volatile("" : "+v"(lane_), "+v"(tid_), "+v"(zlane));
    const int h = grp >> 5, g = grp & 31, lane = lane_, tid = tid_, w = F.wave, r = lane & 15, q = lane >> 4;
    OSet sa, sb;
    oset_load(F, sa, h, g, 0, tid, w, r, q, zlane);
    f32x4 acc[8];
    { const bf16* Sg = F_SGRP + (size_t)grp * 16384 + (16 * w + r) * 128 + 4 * q;
#pragma unroll
      for (int dt = 0; dt < 8; ++dt) { const u32x2 u = *(const GAS u32x2*)(Sg + 16 * dt); acc[dt] = (f32x4){bflo(u.x), bfhi(u.x), bflo(u.y), bfhi(u.y)}; } }
    oset_load(F, sb, h, g, 1, tid, w, r, q, zlane); oset_process(F, sa, acc, h, g, 0, tid, lane, w, r, q);
    oset_load(F, sa, h, g, 2, tid, w, r, q, zlane); oset_process(F, sb, acc, h, g, 1, tid, lane, w, r, q);
    oset_load(F, sb, h, g, 3, tid, w, r, q, zlane); oset_process(F, sa, acc, h, g, 2, tid, lane, w, r, q);
    oset_process(F, sb, acc, h, g, 3, tid, lane, w, r, q);
    LDSW(); wg_sync();
}
DI void final_row(float* row, const float* g, int lane) {
    GAS f32x4* xr = (GAS f32x4*)row + lane; f32x4 v[8]; float s = 0.f;
#pragma unroll
    for (int j = 0; j < 8; ++j) { v[j] = xr[64 * j]; s += (v[j].x * v[j].x + v[j].y * v[j].y) + (v[j].z * v[j].z + v[j].w * v[j].w); }
    const float rs = 1.f / sqrtf(wave_sum(s) * (1.f / DM) + EPSF);
#pragma unroll
    for (int j = 0; j < 8; ++j) { const f32x4 gg = ((const GAS f32x4*)g)[64 * j + lane]; xr[64 * j] = v[j] * rs * gg; }
}
struct Args { const float* in[16]; float* out; unsigned char* ws; int ph_lo, ph_hi, li, pad; };
__global__ void __launch_bounds__(NWAVES * 64, 2) fwd_kernel(Args args) {
    extern __shared__ __attribute__((aligned(16))) unsigned char lds[];
    Frame F;
    F.lds = (LAS unsigned char*)lds; F.MISC = (volatile LAS unsigned*)(F.lds + MISC_OFF);
    F.tid = threadIdx.x; F.lane = F.tid & 63; F.wave = __builtin_amdgcn_readfirstlane(F.tid >> 6);
    F.G = gridDim.x; { const int bx = blockIdx.x; F.vcu = (F.G % 8 == 0) ? (bx % 8) * (F.G / 8) + bx / 8 : bx; }
    F.ws = args.ws; F.out = args.out;
    F.inp = (const float* const*)__builtin_amdgcn_kernarg_segment_ptr();
    for (int u = F.tid; u < (LDS_BYTES - LDSCTL_OFF) / 4; u += NWAVES * 64) ((LAS unsigned*)(F.lds + LDSCTL_OFF))[u] = 0u;
    __syncthreads();
    XcdBarrier bar; bar.bar = (unsigned*)(F_ctl + CW_BAR); bar.x = 0; bar.st = nullptr;
    if (N_LAUNCHES == 1) bar = xcd_barrier_post((unsigned*)(F_ctl + CW_BAR), F.MISC + 8);
#define GRID_BAR() do { if (N_LAUNCHES == 1) xcd_barrier(bar); } while (0)
    const int lo = args.ph_lo, hi = args.ph_hi;
#if defined(DBG_TS_I)
    volatile unsigned long long* tsw = (volatile unsigned long long*)(F.ws + 512 * 1024);
    const bool stamper = (blockIdx.x == 0 && threadIdx.x == 0);
    if (stamper) tsw[15] = __builtin_amdgcn_s_memrealtime();
#define STAMP(k) do { if (stamper) tsw[k] = __builtin_amdgcn_s_memrealtime(); } while (0)
#else
#define STAMP(k) do {} while (0)
#endif
#ifndef ITEM_MASK
#define ITEM_MASK 7
#endif
#ifndef PH_MASK
#define PH_MASK 0x7f
#endif
#define IN(k) (((PH_MASK >> (k)) & 1) && lo <= (k) && (k) < hi)
#define BOTH(k) (IN(k) && IN((k) + 1))
#ifndef REP_MASK
#define REP_MASK 0
#endif
#define REPS(k) for (int rep_ = 0; rep_ <= ((REP_MASK >> (k)) & 1); ++rep_)
#define REFRESH() do { int t_ = threadIdx.x; asm volatile("" : "+v"(t_)); F.tid = t_; F.lane = t_ & 63; } while (0)
    if (IN(0)) REPS(0) { REFRESH(); p0_prologue(F); if (BOTH(0)) GRID_BAR(); STAMP(0); }
    if (IN(1)) REPS(1) {
        pg8::Gemm g{F_XB, F_WTIN, SEQ + NMEMT, NPADC + 1024, DM}; pg8::Order1 S; S.init(F.G, (int)blockIdx.x);
        pg8::EpiProj E{F_P, F_AB, F_RSTD, F_MKV};
        pg8::gemm_phase<pg8::EpiProj, pg8::Order1, true, true>(F.lds, g, S, E);
        if (BOTH(1)) GRID_BAR(); STAMP(1);
    }
    if (IN(2)) REPS(2) {
        REFRESH();
#ifndef REP_ITEM
#define REP_ITEM 0
#endif
        for (int ri_ = 0; ri_ <= (REP_ITEM & 1); ++ri_)
        if (ITEM_MASK & 1) for (int grp = F.vcu; grp < 256; grp += F.G) { f32x4 X[16]; float sigma = 1.f;
#pragma unroll
            for (int et = 0; et < 16; ++et) X[et] = (f32x4){0.f, 0.f, 0.f, 0.f};
#pragma unroll 1
            for (int j = 0; j < 4; ++j) dnprep_item(F, (grp >> 5) * 128 + (grp & 31) * 4 + j, X, sigma, j);
            dngroup_finish(F, grp, X, sigma); }
        for (int ri_ = 0; ri_ <= ((REP_ITEM >> 1) & 1); ++ri_)
        if (ITEM_MASK & 2) for (int it = F.vcu; it < 256; it += F.G) gmlp_item(F, it);
        for (int ri_ = 0; ri_ <= ((REP_ITEM >> 2) & 1); ++ri_)
        if (ITEM_MASK & 4) for (int it = F.vcu; it < 256; it += F.G) xattn_item(F, it);
        if (BOTH(2)) GRID_BAR(); STAMP(2);
    }
    if (IN(3)) REPS(3) { REFRESH(); if (blockIdx.x < 32) scan_slice(F, (int)blockIdx.x & 7, (int)blockIdx.x >> 3); if (BOTH(3)) GRID_BAR(); STAMP(3); }
    if (IN(4)) REPS(4) { REFRESH(); for (int grp = F.vcu; grp < 256; grp += F.G) dnout_group(F, grp); if (BOTH(4)) GRID_BAR(); STAMP(4); }
    if (IN(5)) REPS(5) {
        pg8::Gemm g{F_MIXED, F_WTOUT, SEQ, DM, DM}; pg8::StaticOrder S; S.init(SEQ, DM, F.G, (int)blockIdx.x);
        pg8::EpiRes E{F_x, F.out};
        pg8::gemm_phase<pg8::EpiRes, pg8::StaticOrder, true, true>(F.lds, g, S, E);
        if (BOTH(5)) GRID_BAR(); STAMP(5);
    }
    if (IN(6)) { REFRESH(); const int gw = F.vcu * NWAVES + F.wave, NGW = F.G * NWAVES; for (int m = gw; m < SEQ; m += NGW) final_row(F.out + (size_t)m * DM, F_final_g, F.lane);
#if defined(DBG_TS_I)
        if (stamper) { const float vi = (float)(tsw[DBG_TS_I] - tsw[15]) * 0.01f, vj = (float)(tsw[DBG_TS_J] - tsw[15]) * 0.01f; F.out[0] += vj; for (int j = 1; j < 8; ++j) { F.out[256 * j] += vi; F.out[256 * j + 1] += vi; F.out[256 * j + 2] += vi; F.out[256 * j + 3] += vi; } }
#endif
    }
#undef IN
#undef BOTH
}

extern "C" void kernel_launch(void* const* d_in, const int* in_sizes, int n_in, void* d_out, int out_size, void* d_ws, size_t ws_size, hipStream_t stream) {
    static int grid = 0;
    if (grid == 0) {
        if (n_in != 16 || in_sizes[0] != SEQ * DM || out_size != SEQ * DM || ws_size < WS_END) { fprintf(stderr, "kernel_launch: unexpected shapes (n_in %d, in0 %d, out %d, ws %zu); nothing launched\n", n_in, n_in > 0 ? in_sizes[0] : -1, out_size, ws_size); grid = -1; return; }
        int dev = 0, cus = 0, per_cu = 0;
        if (hipGetDevice(&dev) != hipSuccess || hipDeviceGetAttribute(&cus, hipDeviceAttributeMultiprocessorCount, dev) != hipSuccess) { grid = -1; return; }
        if (hipFuncSetAttribute((const void*)fwd_kernel, hipFuncAttributeMaxDynamicSharedMemorySize, LDS_BYTES) != hipSuccess) { fprintf(stderr, "kernel_launch: hipFuncSetAttribute failed\n"); grid = -1; return; }
        if (hipOccupancyMaxActiveBlocksPerMultiprocessor(&per_cu, (const void*)fwd_kernel, NWAVES * 64, LDS_BYTES) != hipSuccess || per_cu < 1) fprintf(stderr, "kernel_launch: note: occupancy query reports %d\n", per_cu);
        (void)hipGetLastError();
        grid = cus;
    }
    if (grid < 0) return;
    if (hipMemsetAsync((char*)d_ws + WS_CTL, 0, CTL_ZERO_BYTES, stream) != hipSuccess) return;
    Args a{};
    for (int i = 0; i < 16; ++i) a.in[i] = (const float*)d_in[i];
    a.out = (float*)d_out; a.ws = (unsigned char*)d_ws;
    for (int li = 0; li < N_LAUNCHES; ++li) {
        a.ph_lo = (N_LAUNCHES == 1) ? 0 : li; a.ph_hi = (N_LAUNCHES == 1) ? N_PHASES : li + 1; a.li = li;
        hipLaunchKernelGGL(fwd_kernel, dim3(grid), dim3(NWAVES * 64), LDS_BYTES, stream, a);
        if (hipPeekAtLastError() != hipSuccess) { fprintf(stderr, "kernel_launch: launch %d failed\n", li); break; }
    }
}
```
